# Optimizing an MI355X kernel written in HIP

```python
import jax, jax.numpy as jnp
from jax import lax
import numpy as np

D_MODEL = 1024
BATCH = 8
SEQ = 2048
DEPTH = 1

GRID_W = 64
N_ATT_HEADS = 8
ATT_HEAD_DIM = 64
D_ATT = N_ATT_HEADS * ATT_HEAD_DIM
WIN_H_MAX = 8
WIN_W = 16
Q_BLOCK_W = 16
KV_BLOCK_W = Q_BLOCK_W + WIN_W
N_COL_BLOCKS = GRID_W // Q_BLOCK_W
D_REC = D_MODEL
N_REC_BLOCKS = 16
REC_BLOCK = D_REC // N_REC_BLOCKS
CONV_W = 4
LRU_C = 8.0
N_DIR = 2
D_FF = 4 * D_MODEL
EPS = 1e-6
D_IN = 3 * D_ATT + 2 * D_REC + 2 * D_MODEL
SPLITS = [int(v) for v in np.cumsum([D_ATT, D_ATT, D_ATT, D_REC, D_REC, D_MODEL])]

kernel_name = "hybrid_natten_rglru_gated_encoder"


def rms_norm(x, g):
    x32 = x.astype(jnp.float32)
    y = x32 * lax.rsqrt(jnp.mean(x32 * x32, axis=-1, keepdims=True) + EPS)
    return (y * g.astype(jnp.float32)).astype(x.dtype)


def neighbourhood_attention(q, k, v, rpb):
    b, s, h, dh = q.shape
    rows = s // GRID_W
    kh = min(WIN_H_MAX, rows)
    r = np.arange(rows)
    row_start = np.clip(r - kh // 2, 0, rows - kh)
    row_idx = row_start[:, None] + np.arange(kh)[None, :]
    n = np.arange(N_COL_BLOCKS)
    col_start = np.clip(n * Q_BLOCK_W - WIN_W // 2, 0, GRID_W - KV_BLOCK_W)
    col_idx = col_start[:, None] + np.arange(KV_BLOCK_W)[None, :]
    qc = n[:, None] * Q_BLOCK_W + np.arange(Q_BLOCK_W)[None, :]
    win_start = np.clip(qc - WIN_W // 2, 0, GRID_W - WIN_W)
    kc = col_idx[:, None, :]
    valid = (kc >= win_start[..., None]) & (kc < win_start[..., None] + WIN_W)
    d_row = row_idx - r[:, None] + (WIN_H_MAX - 1)
    d_col = np.clip(kc - qc[..., None], -(WIN_W - 1), WIN_W - 1) + (WIN_W - 1)

    scale = ATT_HEAD_DIM ** -0.5
    q_blk = (q * scale).reshape(b, rows, N_COL_BLOCKS, Q_BLOCK_W, h, dh).transpose(0, 4, 1, 2, 3, 5)
    k_grid = k.reshape(b, rows, GRID_W, h, dh).transpose(0, 3, 1, 2, 4)
    v_grid = v.reshape(b, rows, GRID_W, h, dh).transpose(0, 3, 1, 2, 4)
    ri = row_idx[:, None, :, None]
    ci = col_idx[None, :, None, :]
    kg = k_grid[:, :, ri, ci]
    vg = v_grid[:, :, ri, ci]

    scores = jnp.einsum('bhrnqd,bhrnikd->bhrnqik', q_blk, kg).astype(jnp.float32)
    bias = rpb.astype(jnp.float32)[:, d_row[:, None, None, :, None], d_col[None, :, :, None, :]]
    scores = scores + bias[None]
    scores = jnp.where(valid[:, :, None, :], scores, -1e30)
    probs = jax.nn.softmax(scores, axis=(-2, -1)).astype(v.dtype)
    out = jnp.einsum('bhrnqik,bhrnikd->bhrnqd', probs, vg)
    return out.transpose(0, 2, 3, 4, 1, 5).reshape(b, s, h * dh)


def centred_depthwise_conv(u, w, bias):
    s = u.shape[1]
    left = CONV_W // 2
    right = CONV_W - 1 - left
    up = jnp.pad(u, ((0, 0), (left, right), (0, 0)))
    out = bias
    for j in range(CONV_W):
        out = out + up[:, j:j + s] * w[j]
    return out


def block_diag_linear(u, w, b):
    bsz, s, c = u.shape
    ub = u.reshape(bsz, s, N_REC_BLOCKS, REC_BLOCK)
    return jnp.einsum('bsnc,ncd->bsnd', ub, w).reshape(bsz, s, c) + b


def rg_lru(u, w_a, b_a, w_i, b_i, lam, reverse):
    r_gate = jax.nn.sigmoid(block_diag_linear(u, w_a, b_a)).astype(jnp.float32)
    i_gate = jax.nn.sigmoid(block_diag_linear(u, w_i, b_i))
    log_a = -LRU_C * r_gate * jax.nn.softplus(-lam.astype(jnp.float32))
    a = jnp.exp(log_a)
    mult = jnp.sqrt(jnp.maximum(-jnp.expm1(2.0 * log_a), 0.0))
    bx = mult * (i_gate * u).astype(jnp.float32)

    def combine(c1, c2):
        a1, b1 = c1
        a2, b2 = c2
        return a1 * a2, a2 * b1 + b2

    _, h = lax.associative_scan(combine, (a, bx), axis=1, reverse=reverse)
    return h.astype(u.dtype)


def setup_inputs(seed: int = 0) -> dict:
    key = jax.random.key(seed)
    ks = jax.random.split(key, 20)
    f32 = jnp.float32
    nrm = lambda k, shape, fan_in: jax.random.normal(k, shape, f32) * (fan_in ** -0.5)
    x = jax.random.normal(ks[0], (BATCH, SEQ, D_MODEL), f32)
    ln1_g = 1.0 + 0.05 * jax.random.normal(ks[1], (DEPTH, D_MODEL), f32)
    w_in = nrm(ks[2], (DEPTH, D_MODEL, D_IN), D_MODEL)
    b_in = 0.02 * jax.random.normal(ks[3], (DEPTH, D_IN), f32)
    rpb = 0.02 * jax.random.normal(ks[4], (DEPTH, N_ATT_HEADS, 2 * WIN_H_MAX - 1, 2 * WIN_W - 1), f32)
    w_att_o = nrm(ks[5], (DEPTH, D_ATT, D_MODEL), D_ATT)
    conv_w = nrm(ks[6], (DEPTH, CONV_W, D_REC), CONV_W)
    conv_b = 0.02 * jax.random.normal(ks[7], (DEPTH, D_REC), f32)
    w_rg_a = nrm(ks[8], (DEPTH, N_DIR, N_REC_BLOCKS, REC_BLOCK, REC_BLOCK), REC_BLOCK)
    b_rg_a = 0.02 * jax.random.normal(ks[9], (DEPTH, N_DIR, D_REC), f32)
    w_rg_i = nrm(ks[10], (DEPTH, N_DIR, N_REC_BLOCKS, REC_BLOCK, REC_BLOCK), REC_BLOCK)
    b_rg_i = 0.02 * jax.random.normal(ks[11], (DEPTH, N_DIR, D_REC), f32)
    a_c = jax.random.uniform(ks[12], (DEPTH, N_DIR, D_REC), f32, 0.9, 0.999)
    a0 = a_c ** (1.0 / LRU_C)
    lru_lambda = jnp.log(a0) - jnp.log1p(-a0)
    w_rec_o = nrm(ks[13], (DEPTH, D_REC, D_MODEL), D_REC)
    w_out = nrm(ks[14], (DEPTH, D_MODEL, D_MODEL), D_MODEL)
    ln2_g = 1.0 + 0.05 * jax.random.normal(ks[15], (DEPTH, D_MODEL), f32)
    w_ff1 = nrm(ks[16], (DEPTH, D_MODEL, D_FF), D_MODEL)
    w_ff2 = nrm(ks[17], (DEPTH, D_FF, D_MODEL), D_FF)
    lnf_g = 1.0 + 0.05 * jax.random.normal(ks[18], (D_MODEL,), f32)
    return {"x": x, "ln1_g": ln1_g, "w_in": w_in, "b_in": b_in, "rpb": rpb,
            "w_att_o": w_att_o, "conv_w": conv_w, "conv_b": conv_b,
            "w_rg_a": w_rg_a, "b_rg_a": b_rg_a, "w_rg_i": w_rg_i, "b_rg_i": b_rg_i,
            "lru_lambda": lru_lambda, "w_rec_o": w_rec_o, "w_out": w_out,
            "ln2_g": ln2_g, "w_ff1": w_ff1, "w_ff2": w_ff2, "lnf_g": lnf_g}


def reference(x, ln1_g, w_in, b_in, rpb, w_att_o, conv_w, conv_b, w_rg_a, b_rg_a,
              w_rg_i, b_rg_i, lru_lambda, w_rec_o, w_out, ln2_g, w_ff1, w_ff2, lnf_g):
    b, s, _ = x.shape
    for l in range(DEPTH):
        h = rms_norm(x, ln1_g[l])
        z = h @ w_in[l] + b_in[l]
        q, k, v, u, y_branch, g_att, g_rec = jnp.split(z, SPLITS, axis=-1)

        q = q.reshape(b, s, N_ATT_HEADS, ATT_HEAD_DIM)
        k = k.reshape(b, s, N_ATT_HEADS, ATT_HEAD_DIM)
        v = v.reshape(b, s, N_ATT_HEADS, ATT_HEAD_DIM)
        y_att = neighbourhood_attention(q, k, v, rpb[l]) @ w_att_o[l]

        u = centred_depthwise_conv(u, conv_w[l], conv_b[l])
        h_fwd = rg_lru(u, w_rg_a[l, 0], b_rg_a[l, 0], w_rg_i[l, 0], b_rg_i[l, 0], lru_lambda[l, 0], False)
        h_bwd = rg_lru(u, w_rg_a[l, 1], b_rg_a[l, 1], w_rg_i[l, 1], b_rg_i[l, 1], lru_lambda[l, 1], True)
        y_rec = ((h_fwd + h_bwd) * jax.nn.gelu(y_branch)) @ w_rec_o[l]

        mixed = jax.nn.sigmoid(g_att) * y_att + jax.nn.sigmoid(g_rec) * y_rec
        x = x + mixed @ w_out[l]

        h2 = rms_norm(x, ln2_g[l])
        x = x + jnp.square(jax.nn.relu(h2 @ w_ff1[l])) @ w_ff2[l]
    return rms_norm(x, lnf_g)
```

```cpp
#include <hip/hip_runtime.h>
#include <cstdint>
#include <cstdio>

typedef unsigned short bf16;
typedef short bf16x8 __attribute__((ext_vector_type(8)));
typedef short bf16x4 __attribute__((ext_vector_type(4)));
typedef float f32x4 __attribute__((ext_vector_type(4)));
typedef unsigned u32x4 __attribute__((ext_vector_type(4)));
typedef unsigned u32x2 __attribute__((ext_vector_type(2)));

constexpr int NB = 8, SEQ = 2048, D = 1024, M = NB * SEQ;
constexpr int DATT = 512, NH = 8, HD = 64, DREC = 1024, DIN = 5632, DFF = 4096;
constexpr int GRIDW = 64, ROWS = 32;
constexpr int KCAT = DATT + DREC;
constexpr int NCHUNK = 32, TCH = 64;
constexpr float EPS = 1e-6f;
constexpr float LOG2E = 1.4426950408889634f;

constexpr size_t MiB = 1u << 20;
constexpr size_t WS_CTL = 0;
constexpr size_t WS_CAR = 1 * MiB;
constexpr size_t WS_SS1 = 5 * MiB;
constexpr size_t WS_SS2 = 5 * MiB + 512 * 1024;
constexpr size_t WS_WG = 6 * MiB;
constexpr size_t WS_WIN = 8 * MiB;
constexpr size_t WS_WCAT = 19 * MiB;
constexpr size_t WS_WOUT = 22 * MiB;
constexpr size_t WS_WFF1 = 24 * MiB;
constexpr size_t WS_WFF2 = 32 * MiB;
constexpr size_t WS_XN = 40 * MiB;
constexpr size_t WS_MIXED = 40 * MiB;
constexpr size_t WS_U = 72 * MiB;
constexpr size_t WS_X1B = 72 * MiB;
constexpr size_t WS_ACAT = 104 * MiB;
constexpr size_t WS_K = 152 * MiB;
constexpr size_t WS_VT = 168 * MiB;
constexpr size_t WS_RATIO = 184 * MiB;
constexpr size_t WS_SR = 216 * MiB;
constexpr size_t WS_HFF = 104 * MiB;
constexpr size_t WS_END = 248 * MiB;

__device__ __forceinline__ unsigned f2bf(float f) { unsigned u = __builtin_bit_cast(unsigned, f); return (u + 0x7fffu + ((u >> 16) & 1u)) >> 16; }
__device__ __forceinline__ float bf2f(unsigned short h) { return __builtin_bit_cast(float, ((unsigned)h) << 16); }
__device__ __forceinline__ unsigned pk2(float lo, float hi) { return f2bf(lo) | (f2bf(hi) << 16); }
__device__ __forceinline__ float sigmoidf_(float x) { return 1.0f / (1.0f + exp2f(-x * LOG2E)); }
__device__ __forceinline__ float gelu_tanh(float x) { const float z = 1.5957691216057308f * (x + 0.044715f * x * x * x); return x * sigmoidf_(z); }
__device__ __forceinline__ float wave_sum(float v) {
#pragma unroll
    for (int o = 1; o < 64; o <<= 1) v += __shfl_xor(v, o);
    return v;
}
__device__ __forceinline__ bf16x8 pack8(const float* v) {
    u32x4 w; w.x = pk2(v[0], v[1]); w.y = pk2(v[2], v[3]); w.z = pk2(v[4], v[5]); w.w = pk2(v[6], v[7]);
    return __builtin_bit_cast(bf16x8, w);
}

__device__ __forceinline__ void transpose_item(const float* W, int N, int k0, int n0, bf16* dst, int dpitch, int drow0, int dcol0,
                                               const float* kscale, float* scr, int lane) {
#pragma unroll 8
    for (int i = 0; i < 32; ++i) {
        const int kk = 2 * i + (lane >> 5);
        float v = W[(size_t)(k0 + kk) * N + n0 + (lane & 31)];
        if (kscale) v *= kscale[k0 + kk];
        scr[kk * 33 + (lane & 31)] = v;
    }
    __builtin_amdgcn_s_waitcnt(0xc07f);
    asm volatile("" ::: "memory");
    const int c = lane & 7;
#pragma unroll
    for (int j = 0; j < 4; ++j) {
        const int n = (lane >> 3) + 8 * j; const float* s = scr + (8 * c) * 33 + n;
        u32x4 o; o.x = pk2(s[0 * 33], s[1 * 33]); o.y = pk2(s[2 * 33], s[3 * 33]); o.z = pk2(s[4 * 33], s[5 * 33]); o.w = pk2(s[6 * 33], s[7 * 33]);
        *(u32x4*)(dst + (size_t)(drow0 + n0 + n) * dpitch + dcol0 + k0 + 8 * c) = o;
    }
    __builtin_amdgcn_s_waitcnt(0xc07f);
    asm volatile("" ::: "memory");
}

struct Ptrs {
    const float *x, *ln1_g, *w_in, *b_in, *rpb, *w_att_o, *conv_w, *conv_b, *w_rg_a, *b_rg_a, *w_rg_i, *b_rg_i, *lam, *w_rec_o, *w_out, *ln2_g, *w_ff1, *w_ff2, *lnf_g;
    float* out; unsigned char* ws;
};

__device__ __forceinline__ int win_dest_row(int n0) {
    if (n0 < 3584) return n0;
    if (n0 < 4608) { const int c = n0 - 3584; return 3584 + 256 * (c >> 7) + (c & 127); }
    const int c = n0 - 4608; return 3584 + 256 * (c >> 7) + 128 + (c & 127);
}

__device__ __forceinline__ void p0_prologue(const Ptrs& P, float* scr, int gw, int ngw, int lane) {
    bf16* WIN = (bf16*)(P.ws + WS_WIN); bf16* WCAT = (bf16*)(P.ws + WS_WCAT); bf16* WOUT = (bf16*)(P.ws + WS_WOUT);
    bf16* WFF1 = (bf16*)(P.ws + WS_WFF1); bf16* WFF2 = (bf16*)(P.ws + WS_WFF2); bf16* WG = (bf16*)(P.ws + WS_WG);
    constexpr int I_IN = 16 * 176, I_AO = 8 * 32, I_RO = 16 * 32, I_OUT = 16 * 32, I_F1 = 16 * 128, I_F2 = 64 * 32, I_G = 128;
    constexpr int NITEMS = I_IN + I_AO + I_RO + I_OUT + I_F1 + I_F2 + I_G;
    for (int it = gw; it < NITEMS; it += ngw) {
        int r = it;
        if (r < I_IN) { const int kb = r / 176, nb = r % 176; transpose_item(P.w_in, DIN, 64 * kb, 32 * nb, WIN, D, win_dest_row(32 * nb) - 32 * nb, 0, nullptr, scr, lane); continue; } r -= I_IN;
        if (r < I_AO) { const int kb = r / 32, nb = r % 32; transpose_item(P.w_att_o, D, 64 * kb, 32 * nb, WCAT, KCAT, 0, 0, nullptr, scr, lane); continue; } r -= I_AO;
        if (r < I_RO) { const int kb = r / 32, nb = r % 32; transpose_item(P.w_rec_o, D, 64 * kb, 32 * nb, WCAT, KCAT, 0, DATT, nullptr, scr, lane); continue; } r -= I_RO;
        if (r < I_OUT) { const int kb = r / 32, nb = r % 32; transpose_item(P.w_out, D, 64 * kb, 32 * nb, WOUT, D, 0, 0, nullptr, scr, lane); continue; } r -= I_OUT;
        if (r < I_F1) { const int kb = r / 128, nb = r % 128; transpose_item(P.w_ff1, DFF, 64 * kb, 32 * nb, WFF1, D, 0, 0, P.ln2_g, scr, lane); continue; } r -= I_F1;
        if (r < I_F2) { const int kb = r / 32, nb = r % 32; transpose_item(P.w_ff2, D, 64 * kb, 32 * nb, WFF2, DFF, 0, 0, nullptr, scr, lane); continue; } r -= I_F2;
        {
            const int mi = r >> 1, nb = r & 1, blk = mi >> 2, ty = mi & 3, dir = ty >> 1;
            const float* src = ((ty & 1) ? P.w_rg_i : P.w_rg_a) + (size_t)(dir * 16 + blk) * 4096;
            transpose_item(src, 64, 0, 32 * nb, WG + (size_t)mi * 4096, 64, 0, 0, nullptr, scr, lane);
        }
    }
    bf16* XN = (bf16*)(P.ws + WS_XN);
    for (int m = gw; m < M; m += ngw) {
        const f32x4* xr = (const f32x4*)(P.x + (size_t)m * D) + lane;
        f32x4 v[4]; float s = 0.f;
#pragma unroll
        for (int j = 0; j < 4; ++j) { v[j] = xr[64 * j]; s += (v[j].x * v[j].x + v[j].y * v[j].y) + (v[j].z * v[j].z + v[j].w * v[j].w); }
        const float rstd = 1.0f / sqrtf(wave_sum(s) * (1.0f / D) + EPS);
        u32x2* o8 = (u32x2*)(XN + (size_t)m * D) + lane;
#pragma unroll
        for (int j = 0; j < 4; ++j) { const f32x4 g = ((const f32x4*)P.ln1_g)[lane + 64 * j];
            u32x2 w; w.x = pk2(v[j].x * rstd * g.x, v[j].y * rstd * g.y); w.y = pk2(v[j].z * rstd * g.z, v[j].w * rstd * g.w); o8[64 * j] = w; }
    }
}

__global__ void __launch_bounds__(256) k_prologue(Ptrs P) {
    __shared__ float scr_all[4][64 * 33];
    const int lane = threadIdx.x & 63, wave = threadIdx.x >> 6;
    p0_prologue(P, scr_all[wave], blockIdx.x * 4 + wave, gridDim.x * 4, lane);
}

template <class Epi>
__global__ void __launch_bounds__(256) k_gemm_simple(const bf16* A, int lda, const bf16* Bt, int ldb, int K, int khook, Epi epi) {
    const int lane = threadIdx.x & 63, wave = threadIdx.x >> 6, r16 = lane & 15, g = lane >> 4;
    const int row0 = blockIdx.y * 128 + (wave >> 1) * 64, col0 = blockIdx.x * 128 + (wave & 1) * 64;
    f32x4 acc[4][4];
#pragma unroll
    for (int m = 0; m < 4; ++m)
#pragma unroll
        for (int n = 0; n < 4; ++n) acc[m][n] = (f32x4){0.f, 0.f, 0.f, 0.f};
    const bf16* ap = A + (size_t)(row0 + r16) * lda + 8 * g;
    const bf16* bp = Bt + (size_t)(col0 + r16) * ldb + 8 * g;
    for (int k0 = 0; k0 < K; k0 += 32) {
        if (k0 == khook) {
#pragma unroll
            for (int m = 0; m < 4; ++m)
#pragma unroll
                for (int n = 0; n < 4; ++n)
#pragma unroll
                    for (int i = 0; i < 4; ++i) acc[m][n][i] *= epi.hook(row0 + 16 * m + 4 * g + i, col0 + 16 * n + r16);
        }
        bf16x8 a[4], b[4];
#pragma unroll
        for (int m = 0; m < 4; ++m) a[m] = *(const bf16x8*)(ap + (size_t)(16 * m) * lda + k0);
#pragma unroll
        for (int n = 0; n < 4; ++n) b[n] = *(const bf16x8*)(bp + (size_t)(16 * n) * ldb + k0);
#pragma unroll
        for (int m = 0; m < 4; ++m)
#pragma unroll
            for (int n = 0; n < 4; ++n) acc[m][n] = __builtin_amdgcn_mfma_f32_16x16x32_bf16(a[m], b[n], acc[m][n], 0, 0, 0);
    }
#pragma unroll
    for (int m = 0; m < 4; ++m)
#pragma unroll
        for (int n = 0; n < 4; ++n)
#pragma unroll
            for (int i = 0; i < 4; ++i) epi(row0 + 16 * m + 4 * g + i, col0 + 16 * n + r16, acc[m][n][i]);
}

struct EpiP1s {
    const float* b_in; bf16 *ACAT, *Kb, *VT, *U, *RATIO, *SR;
    __device__ __forceinline__ float hook(int, int) const { return 1.f; }
    __device__ __forceinline__ void operator()(int row, int col, float v) const {
        if (col < 3584) {
            v += b_in[col];
            if (col < 512) ACAT[(size_t)row * KCAT + col] = (bf16)f2bf(v * 0.125f);
            else if (col < 1024) Kb[(size_t)row * DATT + (col - 512)] = (bf16)f2bf(v);
            else if (col < 1536) { const int c = col - 1024, h = c >> 6, d = c & 63, b = row >> 11, s = row & 2047; VT[((size_t)((b * NH + h) * HD + d)) * SEQ + s] = (bf16)f2bf(v); }
            else if (col < 2560) U[(size_t)row * DREC + (col - 1536)] = (bf16)f2bf(v);
            else ACAT[(size_t)row * KCAT + DATT + (col - 2560)] = (bf16)f2bf(gelu_tanh(v));
        } else {
            const int j = (col - 3584) >> 8, w = (col - 3584) & 255, isrec = w >> 7, ch = 128 * j + (w & 127);
            v += b_in[(isrec ? 4608 : 3584) + ch];
            (isrec ? SR : RATIO)[(size_t)row * D + ch] = (bf16)f2bf(sigmoidf_(v));
        }
    }
};
__global__ void k_ratio(bf16* RATIO, const bf16* SR, size_t n) {
    for (size_t i = (size_t)blockIdx.x * blockDim.x + threadIdx.x; i < n; i += (size_t)gridDim.x * blockDim.x) RATIO[i] = (bf16)f2bf(bf2f(RATIO[i]) / bf2f(SR[i]));
}
struct EpiP3s {
    const bf16 *RATIO, *SR; bf16* MIXED;
    __device__ __forceinline__ float hook(int row, int col) const { return bf2f(RATIO[(size_t)row * D + col]); }
    __device__ __forceinline__ void operator()(int row, int col, float v) const { MIXED[(size_t)row * D + col] = (bf16)f2bf(v * bf2f(SR[(size_t)row * D + col])); }
};
struct EpiP4s {
    const float* x; float* X1; bf16* X1B;
    __device__ __forceinline__ float hook(int, int) const { return 1.f; }
    __device__ __forceinline__ void operator()(int row, int col, float v) const { const float r = x[(size_t)row * D + col] + v; X1[(size_t)row * D + col] = r; X1B[(size_t)row * D + col] = (bf16)f2bf(r); }
};
struct EpiP5s {
    const float* SS1; bf16* HFF;
    __device__ __forceinline__ float hook(int, int) const { return 1.f; }
    __device__ __forceinline__ void operator()(int row, int col, float v) const {
        const f32x4 s = *(const f32x4*)(SS1 + (size_t)row * 4); const float r2 = 1.0f / (((s.x + s.y) + (s.z + s.w)) * (1.0f / D) + EPS);
        const float t = v > 0.f ? v : 0.f; HFF[(size_t)row * DFF + col] = (bf16)f2bf(t * t * r2);
    }
};
struct EpiP6s {
    float* X;
    __device__ __forceinline__ float hook(int, int) const { return 1.f; }
    __device__ __forceinline__ void operator()(int row, int col, float v) const { X[(size_t)row * D + col] += v; }
};
__global__ void __launch_bounds__(256) k_rowss(const float* X, float* SS) {
    const int lane = threadIdx.x & 63, gw = blockIdx.x * 4 + (threadIdx.x >> 6), ngw = gridDim.x * 4;
    for (int m = gw; m < M; m += ngw) {
        const f32x4* xr = (const f32x4*)(X + (size_t)m * D) + lane; float s = 0.f;
#pragma unroll
        for (int j = 0; j < 4; ++j) { const f32x4 v = xr[64 * j]; s += (v.x * v.x + v.y * v.y) + (v.z * v.z + v.w * v.w); }
        s = wave_sum(s);
        if (lane < 4) SS[(size_t)m * 4 + lane] = lane == 0 ? s : 0.f;
    }
}
__global__ void __launch_bounds__(256) k_final(float* X, const float* g) {
    const int lane = threadIdx.x & 63, gw = blockIdx.x * 4 + (threadIdx.x >> 6), ngw = gridDim.x * 4;
    for (int m = gw; m < M; m += ngw) {
        f32x4* xr = (f32x4*)(X + (size_t)m * D) + lane; f32x4 v[4]; float s = 0.f;
#pragma unroll
        for (int j = 0; j < 4; ++j) { v[j] = xr[64 * j]; s += (v[j].x * v[j].x + v[j].y * v[j].y) + (v[j].z * v[j].z + v[j].w * v[j].w); }
        const float rstd = 1.0f / sqrtf(wave_sum(s) * (1.0f / D) + EPS);
#pragma unroll
        for (int j = 0; j < 4; ++j) { const f32x4 gg = ((const f32x4*)g)[lane + 64 * j]; xr[64 * j] = v[j] * rstd * gg; }
    }
}

__device__ __forceinline__ void attn_unit(int b, int h, int r, int n, bf16* ACAT, const bf16* Kb, const bf16* VT, const float* rpb, int lane) {
    const int r16 = lane & 15, g = lane >> 4;
    const int row_start = min(max(r - 4, 0), ROWS - 8), col_start = min(max(16 * n - 8, 0), GRIDW - 32);
    const size_t tokq = (size_t)b * SEQ + r * GRIDW + 16 * n + r16;
    const bf16x8 qf0 = *(const bf16x8*)(ACAT + tokq * KCAT + h * HD + 8 * g);
    const bf16x8 qf1 = *(const bf16x8*)(ACAT + tokq * KCAT + h * HD + 32 + 8 * g);
    f32x4 s[16];
#pragma unroll
    for (int jt = 0; jt < 16; ++jt) {
        const size_t tokk = (size_t)b * SEQ + (row_start + (jt >> 1)) * GRIDW + col_start + 16 * (jt & 1) + r16;
        const bf16x8 kf0 = *(const bf16x8*)(Kb + tokk * DATT + h * HD + 8 * g);
        const bf16x8 kf1 = *(const bf16x8*)(Kb + tokk * DATT + h * HD + 32 + 8 * g);
        f32x4 z = (f32x4){0.f, 0.f, 0.f, 0.f};
        z = __builtin_amdgcn_mfma_f32_16x16x32_bf16(kf0, qf0, z, 0, 0, 0);
        s[jt] = __builtin_amdgcn_mfma_f32_16x16x32_bf16(kf1, qf1, z, 0, 0, 0);
    }
    const int qc = 16 * n + r16, win_start = min(max(qc - 8, 0), GRIDW - 16);
    const float* rp = rpb + h * (15 * 31);
    float mx = -3.0e38f;
#pragma unroll
    for (int jt = 0; jt < 16; ++jt) {
        const int drow = row_start + (jt >> 1) - r + 7;
#pragma unroll
        for (int i = 0; i < 4; ++i) {
            const int kc = col_start + 16 * (jt & 1) + 4 * g + i; const bool valid = (kc >= win_start) && (kc < win_start + 16);
            const int dcol = min(max(kc - qc + 15, 0), 30);
            const float v = valid ? s[jt][i] + rp[drow * 31 + dcol] : -1.0e30f;
            s[jt][i] = v; mx = fmaxf(mx, v);
        }
    }
    mx = fmaxf(mx, __shfl_xor(mx, 16)); mx = fmaxf(mx, __shfl_xor(mx, 32));
    float sum = 0.f;
#pragma unroll
    for (int jt = 0; jt < 16; ++jt)
#pragma unroll
        for (int i = 0; i < 4; ++i) { const float p = exp2f((s[jt][i] - mx) * LOG2E); s[jt][i] = p; sum += p; }
    sum += __shfl_xor(sum, 16); sum += __shfl_xor(sum, 32);
    const float inv = 1.0f / sum;
    f32x4 o[4];
#pragma unroll
    for (int dt = 0; dt < 4; ++dt) o[dt] = (f32x4){0.f, 0.f, 0.f, 0.f};
#pragma unroll
    for (int sr = 0; sr < 8; ++sr) {
        u32x4 pw; pw.x = pk2(s[2 * sr][0], s[2 * sr][1]); pw.y = pk2(s[2 * sr][2], s[2 * sr][3]); pw.z = pk2(s[2 * sr + 1][0], s[2 * sr + 1][1]); pw.w = pk2(s[2 * sr + 1][2], s[2 * sr + 1][3]);
        const bf16x8 pa = __builtin_bit_cast(bf16x8, pw);
        const int spos = (row_start + sr) * GRIDW + col_start + 4 * g;
#pragma unroll
        for (int dt = 0; dt < 4; ++dt) {
            const bf16* vp = VT + ((size_t)((b * NH + h) * HD + 16 * dt + r16)) * SEQ + spos;
            const u32x2 lo = *(const u32x2*)vp, hi = *(const u32x2*)(vp + 16);
            u32x4 vw; vw.x = lo.x; vw.y = lo.y; vw.z = hi.x; vw.w = hi.y;
            o[dt] = __builtin_amdgcn_mfma_f32_16x16x32_bf16(pa, __builtin_bit_cast(bf16x8, vw), o[dt], 0, 0, 0);
        }
    }
#pragma unroll
    for (int i = 0; i < 4; ++i) {
        const float iq = __shfl(inv, 4 * g + i);
        bf16* op = ACAT + ((size_t)b * SEQ + r * GRIDW + 16 * n + 4 * g + i) * KCAT + h * HD + r16;
#pragma unroll
        for (int dt = 0; dt < 4; ++dt) op[16 * dt] = (bf16)f2bf(o[dt][i] * iq);
    }
}
__global__ void __launch_bounds__(256) k_attn(bf16* ACAT, const bf16* Kb, const bf16* VT, const float* rpb) {
    const int lane = threadIdx.x & 63, gw = blockIdx.x * 4 + (threadIdx.x >> 6), ngw = gridDim.x * 4;
    for (int u = gw; u < NB * NH * ROWS * 4; u += ngw) {
        const int n = u & 3, r = (u >> 2) & 31, h = (u >> 7) & 7, b = u >> 10;
        attn_unit(b, h, r, n, ACAT, Kb, VT, rpb, lane);
    }
}

template <bool FINAL>
__device__ __forceinline__ void rec_unit(int b, int k, int blk, int cg, const Ptrs& P, int lane) {
    const int r16 = lane & 15, g = lane >> 4;
    const bf16* U = (const bf16*)(P.ws + WS_U); const bf16* WG = (const bf16*)(P.ws + WS_WG); float* CAR = (float*)(P.ws + WS_CAR); bf16* ACAT = (bf16*)(P.ws + WS_ACAT);
    const int t0 = TCH * k, ch = 64 * blk + 16 * cg + r16;
    f32x4 acc[5][4];
#pragma unroll
    for (int ty = 0; ty < 5; ++ty)
#pragma unroll
        for (int m = 0; m < 4; ++m) acc[ty][m] = (f32x4){0.f, 0.f, 0.f, 0.f};
#pragma unroll
    for (int ks = 0; ks < 2; ++ks) {
        const int cin0 = 64 * blk + 32 * ks + 8 * g;
        float cw[4][8], cb[8];
#pragma unroll
        for (int jj = 0; jj < 4; ++jj) { const f32x4 w0 = *(const f32x4*)(P.conv_w + jj * DREC + cin0), w1 = *(const f32x4*)(P.conv_w + jj * DREC + cin0 + 4);
            cw[jj][0] = w0.x; cw[jj][1] = w0.y; cw[jj][2] = w0.z; cw[jj][3] = w0.w; cw[jj][4] = w1.x; cw[jj][5] = w1.y; cw[jj][6] = w1.z; cw[jj][7] = w1.w; }
        { const f32x4 w0 = *(const f32x4*)(P.conv_b + cin0), w1 = *(const f32x4*)(P.conv_b + cin0 + 4);
            cb[0] = w0.x; cb[1] = w0.y; cb[2] = w0.z; cb[3] = w0.w; cb[4] = w1.x; cb[5] = w1.y; cb[6] = w1.z; cb[7] = w1.w; }
        bf16x8 wf[4];
#pragma unroll
        for (int ty = 0; ty < 4; ++ty) wf[ty] = *(const bf16x8*)(WG + ((size_t)((blk * 4 + ty) * 64 + 16 * cg + r16)) * 64 + 32 * ks + 8 * g);
        bf16x8 idf;
#pragma unroll
        for (int j = 0; j < 8; ++j) idf[j] = (32 * ks + 8 * g + j == 16 * cg + r16) ? (short)0x3F80 : (short)0;
#pragma unroll
        for (int m = 0; m < 4; ++m) {
            const int tau = 16 * (r16 >> 2) + 4 * m + (r16 & 3);
            float uc[8];
#pragma unroll
            for (int j = 0; j < 8; ++j) uc[j] = cb[j];
#pragma unroll
            for (int jj = 0; jj < 4; ++jj) {
                const int t = t0 + tau + jj - 2;
                if (t >= 0 && t < SEQ) {
                    const bf16x8 u8 = *(const bf16x8*)(U + ((size_t)b * SEQ + t) * DREC + cin0);
#pragma unroll
                    for (int j = 0; j < 8; ++j) uc[j] += bf2f((unsigned short)u8[j]) * cw[jj][j];
                }
            }
            const bf16x8 af = pack8(uc);
#pragma unroll
            for (int ty = 0; ty < 4; ++ty) acc[ty][m] = __builtin_amdgcn_mfma_f32_16x16x32_bf16(af, wf[ty], acc[ty][m], 0, 0, 0);
            if (ks == (cg >> 1)) acc[4][m] = __builtin_amdgcn_mfma_f32_16x16x32_bf16(af, idf, acc[4][m], 0, 0, 0);
        }
    }
#pragma unroll
    for (int dir = 0; dir < 2; ++dir) {
        const float ba = P.b_rg_a[dir * DREC + ch], bi = P.b_rg_i[dir * DREC + ch], lam = P.lam[dir * DREC + ch];
        const float c2 = -8.0f * log1pf(expf(-lam)) * LOG2E;
#pragma unroll
        for (int m = 0; m < 4; ++m)
#pragma unroll
            for (int i = 0; i < 4; ++i) {
                const float rg = sigmoidf_(acc[2 * dir][m][i] + ba), ig = sigmoidf_(acc[2 * dir + 1][m][i] + bi);
                const float a = exp2f(c2 * rg), mult = sqrtf(fmaxf(1.0f - a * a, 0.f));
                acc[2 * dir][m][i] = a; acc[2 * dir + 1][m][i] = mult * ig * acc[4][m][i];
            }
    }
    float Pf = 1.f, Hf = 0.f, Pb = 1.f, Hb = 0.f;
#pragma unroll
    for (int m = 0; m < 4; ++m)
#pragma unroll
        for (int i = 0; i < 4; ++i) { Hf = acc[0][m][i] * Hf + acc[1][m][i]; Pf *= acc[0][m][i]; }
#pragma unroll
    for (int m = 3; m >= 0; --m)
#pragma unroll
        for (int i = 3; i >= 0; --i) { Hb = acc[2][m][i] * Hb + acc[3][m][i]; Pb *= acc[2][m][i]; }
    float Pfx[4], Hfx[4], Pbx[4], Hbx[4];
#pragma unroll
    for (int x = 0; x < 4; ++x) { Pfx[x] = __shfl(Pf, r16 + 16 * x); Hfx[x] = __shfl(Hf, r16 + 16 * x); Pbx[x] = __shfl(Pb, r16 + 16 * x); Hbx[x] = __shfl(Hb, r16 + 16 * x); }
    float* car = CAR + (size_t)(b * NCHUNK) * 4 * DREC + ch;
    if (!FINAL) {
        float Hc = 0.f, Pc = 1.f;
#pragma unroll
        for (int x = 0; x < 4; ++x) { Hc = Hc * Pfx[x] + Hfx[x]; Pc *= Pfx[x]; }
        float Hd = 0.f, Pd = 1.f;
#pragma unroll
        for (int x = 3; x >= 0; --x) { Hd = Hd * Pbx[x] + Hbx[x]; Pd *= Pbx[x]; }
        if (g == 0) { car[(size_t)(k * 4 + 0) * DREC] = Pc; car[(size_t)(k * 4 + 1) * DREC] = Hc; car[(size_t)(k * 4 + 2) * DREC] = Pd; car[(size_t)(k * 4 + 3) * DREC] = Hd; }
    } else {
        float cf = 0.f, cbk = 0.f;
        for (int j = 0; j < k; ++j) cf = cf * car[(size_t)(j * 4 + 0) * DREC] + car[(size_t)(j * 4 + 1) * DREC];
        for (int j = NCHUNK - 1; j > k; --j) cbk = cbk * car[(size_t)(j * 4 + 2) * DREC] + car[(size_t)(j * 4 + 3) * DREC];
#pragma unroll
        for (int x = 0; x < 4; ++x) if (x < g) cf = cf * Pfx[x] + Hfx[x];
#pragma unroll
        for (int x = 3; x >= 0; --x) if (x > g) cbk = cbk * Pbx[x] + Hbx[x];
        float h = cf;
#pragma unroll
        for (int m = 0; m < 4; ++m)
#pragma unroll
            for (int i = 0; i < 4; ++i) { h = acc[0][m][i] * h + acc[1][m][i]; acc[4][m][i] = h; }
        h = cbk;
#pragma unroll
        for (int m = 3; m >= 0; --m)
#pragma unroll
            for (int i = 3; i >= 0; --i) { h = acc[2][m][i] * h + acc[3][m][i]; acc[4][m][i] += h; }
#pragma unroll
        for (int m = 0; m < 4; ++m)
#pragma unroll
            for (int i = 0; i < 4; ++i) {
                bf16* p = ACAT + ((size_t)b * SEQ + t0 + 16 * g + 4 * m + i) * KCAT + DATT + ch;
                *p = (bf16)f2bf(acc[4][m][i] * bf2f(*p));
            }
    }
}
template <bool FINAL>
__global__ void __launch_bounds__(256) k_rec(Ptrs P) {
    const int lane = threadIdx.x & 63, gw = blockIdx.x * 4 + (threadIdx.x >> 6), ngw = gridDim.x * 4;
    for (int u = gw; u < NB * NCHUNK * 16 * 4; u += ngw) {
        const int cg = u & 3, blk = (u >> 2) & 15, k = (u >> 6) & 31, b = u >> 11;
        rec_unit<FINAL>(b, k, blk, cg, P, lane);
    }
}

extern "C" void kernel_launch(void* const* d_in, const int* in_sizes, int n_in, void* d_out, int out_size, void* d_ws, size_t ws_size, hipStream_t stream) {
    if (n_in != 19 || out_size != M * D || ws_size < WS_END) { fprintf(stderr, "kernel_launch: unexpected shapes (n_in %d out %d ws %zu)\n", n_in, out_size, ws_size); return; }
    Ptrs P{};
    const float** pf = (const float**)&P;
    for (int i = 0; i < 19; ++i) pf[i] = (const float*)d_in[i];
    P.out = (float*)d_out; P.ws = (unsigned char*)d_ws;
    unsigned char* ws = P.ws;
    bf16 *XN = (bf16*)(ws + WS_XN), *WIN = (bf16*)(ws + WS_WIN), *ACAT = (bf16*)(ws + WS_ACAT), *Kb = (bf16*)(ws + WS_K), *VT = (bf16*)(ws + WS_VT), *U = (bf16*)(ws + WS_U);
    bf16 *RATIO = (bf16*)(ws + WS_RATIO), *SR = (bf16*)(ws + WS_SR), *WCAT = (bf16*)(ws + WS_WCAT), *MIXED = (bf16*)(ws + WS_MIXED), *WOUT = (bf16*)(ws + WS_WOUT);
    bf16 *X1B = (bf16*)(ws + WS_X1B), *WFF1 = (bf16*)(ws + WS_WFF1), *WFF2 = (bf16*)(ws + WS_WFF2), *HFF = (bf16*)(ws + WS_HFF);
    float* SS1 = (float*)(ws + WS_SS1);

    k_prologue<<<512, 256, 0, stream>>>(P);
    k_gemm_simple<EpiP1s><<<dim3(DIN / 128, M / 128), 256, 0, stream>>>(XN, D, WIN, D, D, -1, EpiP1s{P.b_in, ACAT, Kb, VT, U, RATIO, SR});
    k_ratio<<<2048, 256, 0, stream>>>(RATIO, SR, (size_t)M * D);
    k_attn<<<2048, 256, 0, stream>>>(ACAT, Kb, VT, P.rpb);
    k_rec<false><<<2048, 256, 0, stream>>>(P);
    k_rec<true><<<2048, 256, 0, stream>>>(P);
    k_gemm_simple<EpiP3s><<<dim3(D / 128, M / 128), 256, 0, stream>>>(ACAT, KCAT, WCAT, KCAT, KCAT, DATT, EpiP3s{RATIO, SR, MIXED});
    k_gemm_simple<EpiP4s><<<dim3(D / 128, M / 128), 256, 0, stream>>>(MIXED, D, WOUT, D, D, -1, EpiP4s{P.x, P.out, X1B});
    k_rowss<<<1024, 256, 0, stream>>>(P.out, SS1);
    k_gemm_simple<EpiP5s><<<dim3(DFF / 128, M / 128), 256, 0, stream>>>(X1B, D, WFF1, D, D, -1, EpiP5s{SS1, HFF});
    k_gemm_simple<EpiP6s><<<dim3(D / 128, M / 128), 256, 0, stream>>>(HFF, DFF, WFF2, DFF, DFF, -1, EpiP6s{P.out});
    k_final<<<1024, 256, 0, stream>>>(P.out, P.lnf_g);
}
```

```cpp
#include <hip/hip_runtime.h>
#include <cstdint>
#include <cstdio>

typedef unsigned short bf16;
typedef short bf16x8 __attribute__((ext_vector_type(8)));
typedef short bf16x4 __attribute__((ext_vector_type(4)));
typedef float f32x4 __attribute__((ext_vector_type(4)));
typedef unsigned u32x4 __attribute__((ext_vector_type(4)));
typedef unsigned u32x2 __attribute__((ext_vector_type(2)));

constexpr int NB = 8, SEQ = 2048, D = 1024, M = NB * SEQ;
constexpr int DATT = 512, NH = 8, HD = 64, DREC = 1024, DIN = 5632, DFF = 4096;
constexpr int GRIDW = 64, ROWS = 32;
constexpr int KCAT = DATT + DREC;
constexpr int NCHUNK = 32, TCH = 64;
constexpr float EPS = 1e-6f;
constexpr float LOG2E = 1.4426950408889634f;

constexpr size_t MiB = 1u << 20;
constexpr size_t WS_CTL = 0;
constexpr size_t WS_CAR = 1 * MiB;
constexpr size_t WS_SS1 = 5 * MiB;
constexpr size_t WS_SS2 = 5 * MiB + 512 * 1024;
constexpr size_t WS_WG = 6 * MiB;
constexpr size_t WS_WIN = 8 * MiB;
constexpr size_t WS_WCAT = 19 * MiB;
constexpr size_t WS_WOUT = 22 * MiB;
constexpr size_t WS_WFF1 = 24 * MiB;
constexpr size_t WS_WFF2 = 32 * MiB;
constexpr size_t WS_XN = 40 * MiB;
constexpr size_t WS_MIXED = 40 * MiB;
constexpr size_t WS_U = 72 * MiB;
constexpr size_t WS_X1B = 72 * MiB;
constexpr size_t WS_ACAT = 104 * MiB;
constexpr size_t WS_K = 152 * MiB;
constexpr size_t WS_VT = 168 * MiB;
constexpr size_t WS_RATIO = 184 * MiB;
constexpr size_t WS_SR = 216 * MiB;
constexpr size_t WS_HFF = 104 * MiB;
constexpr size_t WS_END = 248 * MiB;

__device__ __forceinline__ unsigned f2bf(float f) { unsigned u = __builtin_bit_cast(unsigned, f); return (u + 0x7fffu + ((u >> 16) & 1u)) >> 16; }
__device__ __forceinline__ float bf2f(unsigned short h) { return __builtin_bit_cast(float, ((unsigned)h) << 16); }
__device__ __forceinline__ unsigned pk2(float lo, float hi) { return f2bf(lo) | (f2bf(hi) << 16); }
__device__ __forceinline__ float sigmoidf_(float x) { return 1.0f / (1.0f + exp2f(-x * LOG2E)); }
__device__ __forceinline__ float gelu_tanh(float x) { const float z = 1.5957691216057308f * (x + 0.044715f * x * x * x); return x * sigmoidf_(z); }
__device__ __forceinline__ float wave_sum(float v) {
#pragma unroll
    for (int o = 1; o < 64; o <<= 1) v += __shfl_xor(v, o);
    return v;
}
__device__ __forceinline__ bf16x8 pack8(const float* v) {
    u32x4 w; w.x = pk2(v[0], v[1]); w.y = pk2(v[2], v[3]); w.z = pk2(v[4], v[5]); w.w = pk2(v[6], v[7]);
    return __builtin_bit_cast(bf16x8, w);
}

__device__ __forceinline__ void transpose_item(const float* W, int N, int k0, int n0, bf16* dst, int dpitch, int drow0, int dcol0,
                                               const float* kscale, float* scr, int lane) {
#pragma unroll 8
    for (int i = 0; i < 32; ++i) {
        const int kk = 2 * i + (lane >> 5);
        float v = W[(size_t)(k0 + kk) * N + n0 + (lane & 31)];
        if (kscale) v *= kscale[k0 + kk];
        scr[kk * 33 + (lane & 31)] = v;
    }
    __builtin_amdgcn_s_waitcnt(0xc07f);
    asm volatile("" ::: "memory");
    const int c = lane & 7;
#pragma unroll
    for (int j = 0; j < 4; ++j) {
        const int n = (lane >> 3) + 8 * j; const float* s = scr + (8 * c) * 33 + n;
        u32x4 o; o.x = pk2(s[0 * 33], s[1 * 33]); o.y = pk2(s[2 * 33], s[3 * 33]); o.z = pk2(s[4 * 33], s[5 * 33]); o.w = pk2(s[6 * 33], s[7 * 33]);
        *(u32x4*)(dst + (size_t)(drow0 + n0 + n) * dpitch + dcol0 + k0 + 8 * c) = o;
    }
    __builtin_amdgcn_s_waitcnt(0xc07f);
    asm volatile("" ::: "memory");
}

struct Ptrs {
    const float *x, *ln1_g, *w_in, *b_in, *rpb, *w_att_o, *conv_w, *conv_b, *w_rg_a, *b_rg_a, *w_rg_i, *b_rg_i, *lam, *w_rec_o, *w_out, *ln2_g, *w_ff1, *w_ff2, *lnf_g;
    float* out; unsigned char* ws;
};

__device__ __forceinline__ int win_dest_row(int n0) {
    if (n0 < 3584) return n0;
    if (n0 < 4608) { const int c = n0 - 3584; return 3584 + 256 * (c >> 7) + (c & 127); }
    const int c = n0 - 4608; return 3584 + 256 * (c >> 7) + 128 + (c & 127);
}

__device__ __forceinline__ void p0_prologue(const Ptrs& P, float* scr, int gw, int ngw, int lane) {
    bf16* WIN = (bf16*)(P.ws + WS_WIN); bf16* WCAT = (bf16*)(P.ws + WS_WCAT); bf16* WOUT = (bf16*)(P.ws + WS_WOUT);
    bf16* WFF1 = (bf16*)(P.ws + WS_WFF1); bf16* WFF2 = (bf16*)(P.ws + WS_WFF2); bf16* WG = (bf16*)(P.ws + WS_WG);
    constexpr int I_IN = 16 * 176, I_AO = 8 * 32, I_RO = 16 * 32, I_OUT = 16 * 32, I_F1 = 16 * 128, I_F2 = 64 * 32, I_G = 128;
    constexpr int NITEMS = I_IN + I_AO + I_RO + I_OUT + I_F1 + I_F2 + I_G;
    for (int it = gw; it < NITEMS; it += ngw) {
        int r = it;
        if (r < I_IN) { const int kb = r / 176, nb = r % 176; transpose_item(P.w_in, DIN, 64 * kb, 32 * nb, WIN, D, win_dest_row(32 * nb) - 32 * nb, 0, nullptr, scr, lane); continue; } r -= I_IN;
        if (r < I_AO) { const int kb = r / 32, nb = r % 32; transpose_item(P.w_att_o, D, 64 * kb, 32 * nb, WCAT, KCAT, 0, 0, nullptr, scr, lane); continue; } r -= I_AO;
        if (r < I_RO) { const int kb = r / 32, nb = r % 32; transpose_item(P.w_rec_o, D, 64 * kb, 32 * nb, WCAT, KCAT, 0, DATT, nullptr, scr, lane); continue; } r -= I_RO;
        if (r < I_OUT) { const int kb = r / 32, nb = r % 32; transpose_item(P.w_out, D, 64 * kb, 32 * nb, WOUT, D, 0, 0, nullptr, scr, lane); continue; } r -= I_OUT;
        if (r < I_F1) { const int kb = r / 128, nb = r % 128; transpose_item(P.w_ff1, DFF, 64 * kb, 32 * nb, WFF1, D, 0, 0, P.ln2_g, scr, lane); continue; } r -= I_F1;
        if (r < I_F2) { const int kb = r / 32, nb = r % 32; transpose_item(P.w_ff2, D, 64 * kb, 32 * nb, WFF2, DFF, 0, 0, nullptr, scr, lane); continue; } r -= I_F2;
        {
            const int mi = r >> 1, nb = r & 1, blk = mi >> 2, ty = mi & 3, dir = ty >> 1;
            const float* src = ((ty & 1) ? P.w_rg_i : P.w_rg_a) + (size_t)(dir * 16 + blk) * 4096;
            transpose_item(src, 64, 0, 32 * nb, WG + (size_t)mi * 4096, 64, 0, 0, nullptr, scr, lane);
        }
    }
    bf16* XN = (bf16*)(P.ws + WS_XN);
    for (int m = gw; m < M; m += ngw) {
        const f32x4* xr = (const f32x4*)(P.x + (size_t)m * D) + lane;
        f32x4 v[4]; float s = 0.f;
#pragma unroll
        for (int j = 0; j < 4; ++j) { v[j] = xr[64 * j]; s += (v[j].x * v[j].x + v[j].y * v[j].y) + (v[j].z * v[j].z + v[j].w * v[j].w); }
        const float rstd = 1.0f / sqrtf(wave_sum(s) * (1.0f / D) + EPS);
        u32x2* o8 = (u32x2*)(XN + (size_t)m * D) + lane;
#pragma unroll
        for (int j = 0; j < 4; ++j) { const f32x4 g = ((const f32x4*)P.ln1_g)[lane + 64 * j];
            u32x2 w; w.x = pk2(v[j].x * rstd * g.x, v[j].y * rstd * g.y); w.y = pk2(v[j].z * rstd * g.z, v[j].w * rstd * g.w); o8[64 * j] = w; }
    }
}

__global__ void __launch_bounds__(256) k_prologue(Ptrs P) {
    __shared__ float scr_all[4][64 * 33];
    const int lane = threadIdx.x & 63, wave = threadIdx.x >> 6;
    p0_prologue(P, scr_all[wave], blockIdx.x * 4 + wave, gridDim.x * 4, lane);
}

template <class Epi>
__global__ void __launch_bounds__(256) k_gemm_simple(const bf16* A, int lda, const bf16* Bt, int ldb, int K, int khook, Epi epi) {
    const int lane = threadIdx.x & 63, wave = threadIdx.x >> 6, r16 = lane & 15, g = lane >> 4;
    const int row0 = blockIdx.y * 128 + (wave >> 1) * 64, col0 = blockIdx.x * 128 + (wave & 1) * 64;
    f32x4 acc[4][4];
#pragma unroll
    for (int m = 0; m < 4; ++m)
#pragma unroll
        for (int n = 0; n < 4; ++n) acc[m][n] = (f32x4){0.f, 0.f, 0.f, 0.f};
    const bf16* ap = A + (size_t)(row0 + r16) * lda + 8 * g;
    const bf16* bp = Bt + (size_t)(col0 + r16) * ldb + 8 * g;
    for (int k0 = 0; k0 < K; k0 += 32) {
        if (k0 == khook) {
#pragma unroll
            for (int m = 0; m < 4; ++m)
#pragma unroll
                for (int n = 0; n < 4; ++n)
#pragma unroll
                    for (int i = 0; i < 4; ++i) acc[m][n][i] *= epi.hook(row0 + 16 * m + 4 * g + i, col0 + 16 * n + r16);
        }
        bf16x8 a[4], b[4];
#pragma unroll
        for (int m = 0; m < 4; ++m) a[m] = *(const bf16x8*)(ap + (size_t)(16 * m) * lda + k0);
#pragma unroll
        for (int n = 0; n < 4; ++n) b[n] = *(const bf16x8*)(bp + (size_t)(16 * n) * ldb + k0);
#pragma unroll
        for (int m = 0; m < 4; ++m)
#pragma unroll
            for (int n = 0; n < 4; ++n) acc[m][n] = __builtin_amdgcn_mfma_f32_16x16x32_bf16(a[m], b[n], acc[m][n], 0, 0, 0);
    }
#pragma unroll
    for (int m = 0; m < 4; ++m)
#pragma unroll
        for (int n = 0; n < 4; ++n)
#pragma unroll
            for (int i = 0; i < 4; ++i) epi(row0 + 16 * m + 4 * g + i, col0 + 16 * n + r16, acc[m][n][i]);
}

struct EpiP1s {
    const float* b_in; bf16 *ACAT, *Kb, *VT, *U, *RATIO, *SR;
    __device__ __forceinline__ float hook(int, int) const { return 1.f; }
    __device__ __forceinline__ void operator()(int row, int col, float v) const {
        if (col < 3584) {
            v += b_in[col];
            if (col < 512) ACAT[(size_t)row * KCAT + col] = (bf16)f2bf(v * 0.125f);
            else if (col < 1024) Kb[(size_t)row * DATT + (col - 512)] = (bf16)f2bf(v);
            else if (col < 1536) { const int c = col - 1024, h = c >> 6, d = c & 63, b = row >> 11, s = row & 2047; VT[((size_t)((b * NH + h) * HD + d)) * SEQ + s] = (bf16)f2bf(v); }
            else if (col < 2560) U[(size_t)row * DREC + (col - 1536)] = (bf16)f2bf(v);
            else ACAT[(size_t)row * KCAT + DATT + (col - 2560)] = (bf16)f2bf(gelu_tanh(v));
        } else {
            const int j = (col - 3584) >> 8, w = (col - 3584) & 255, isrec = w >> 7, ch = 128 * j + (w & 127);
            v += b_in[(isrec ? 4608 : 3584) + ch];
            (isrec ? SR : RATIO)[(size_t)row * D + ch] = (bf16)f2bf(sigmoidf_(v));
        }
    }
};
__global__ void k_ratio(bf16* RATIO, const bf16* SR, size_t n) {
    for (size_t i = (size_t)blockIdx.x * blockDim.x + threadIdx.x; i < n; i += (size_t)gridDim.x * blockDim.x) RATIO[i] = (bf16)f2bf(bf2f(RATIO[i]) / bf2f(SR[i]));
}
struct EpiP3s {
    const bf16 *RATIO, *SR; bf16* MIXED;
    __device__ __forceinline__ float hook(int row, int col) const { return bf2f(RATIO[(size_t)row * D + col]); }
    __device__ __forceinline__ void operator()(int row, int col, float v) const { MIXED[(size_t)row * D + col] = (bf16)f2bf(v * bf2f(SR[(size_t)row * D + col])); }
};
struct EpiP4s {
    const float* x; float* X1; bf16* X1B;
    __device__ __forceinline__ float hook(int, int) const { return 1.f; }
    __device__ __forceinline__ void operator()(int row, int col, float v) const { const float r = x[(size_t)row * D + col] + v; X1[(size_t)row * D + col] = r; X1B[(size_t)row * D + col] = (bf16)f2bf(r); }
};
struct EpiP5s {
    const float* SS1; bf16* HFF;
    __device__ __forceinline__ float hook(int, int) const { return 1.f; }
    __device__ __forceinline__ void operator()(int row, int col, float v) const {
        const f32x4 s = *(const f32x4*)(SS1 + (size_t)row * 4); const float r2 = 1.0f / (((s.x + s.y) + (s.z + s.w)) * (1.0f / D) + EPS);
        const float t = v > 0.f ? v : 0.f; HFF[(size_t)row * DFF + col] = (bf16)f2bf(t * t * r2);
    }
};
struct EpiP6s {
    float* X;
    __device__ __forceinline__ float hook(int, int) const { return 1.f; }
    __device__ __forceinline__ void operator()(int row, int col, float v) const { X[(size_t)row * D + col] += v; }
};
__global__ void __launch_bounds__(256) k_rowss(const float* X, float* SS) {
    const int lane = threadIdx.x & 63, gw = blockIdx.x * 4 + (threadIdx.x >> 6), ngw = gridDim.x * 4;
    for (int m = gw; m < M; m += ngw) {
        const f32x4* xr = (const f32x4*)(X + (size_t)m * D) + lane; float s = 0.f;
#pragma unroll
        for (int j = 0; j < 4; ++j) { const f32x4 v = xr[64 * j]; s += (v.x * v.x + v.y * v.y) + (v.z * v.z + v.w * v.w); }
        s = wave_sum(s);
        if (lane < 4) SS[(size_t)m * 4 + lane] = lane == 0 ? s : 0.f;
    }
}
__global__ void __launch_bounds__(256) k_final(float* X, const float* g) {
    const int lane = threadIdx.x & 63, gw = blockIdx.x * 4 + (threadIdx.x >> 6), ngw = gridDim.x * 4;
    for (int m = gw; m < M; m += ngw) {
        f32x4* xr = (f32x4*)(X + (size_t)m * D) + lane; f32x4 v[4]; float s = 0.f;
#pragma unroll
        for (int j = 0; j < 4; ++j) { v[j] = xr[64 * j]; s += (v[j].x * v[j].x + v[j].y * v[j].y) + (v[j].z * v[j].z + v[j].w * v[j].w); }
        const float rstd = 1.0f / sqrtf(wave_sum(s) * (1.0f / D) + EPS);
#pragma unroll
        for (int j = 0; j < 4; ++j) { const f32x4 gg = ((const f32x4*)g)[lane + 64 * j]; xr[64 * j] = v[j] * rstd * gg; }
    }
}

__device__ __forceinline__ void attn_unit(int b, int h, int r, int n, bf16* ACAT, const bf16* Kb, const bf16* VT, const float* rpb, int lane) {
    const int r16 = lane & 15, g = lane >> 4;
    const int row_start = min(max(r - 4, 0), ROWS - 8), col_start = min(max(16 * n - 8, 0), GRIDW - 32);
    const size_t tokq = (size_t)b * SEQ + r * GRIDW + 16 * n + r16;
    const bf16x8 qf0 = *(const bf16x8*)(ACAT + tokq * KCAT + h * HD + 8 * g);
    const bf16x8 qf1 = *(const bf16x8*)(ACAT + tokq * KCAT + h * HD + 32 + 8 * g);
    f32x4 s[16];
#pragma unroll
    for (int jt = 0; jt < 16; ++jt) {
        const size_t tokk = (size_t)b * SEQ + (row_start + (jt >> 1)) * GRIDW + col_start + 16 * (jt & 1) + r16;
        const bf16x8 kf0 = *(const bf16x8*)(Kb + tokk * DATT + h * HD + 8 * g);
        const bf16x8 kf1 = *(const bf16x8*)(Kb + tokk * DATT + h * HD + 32 + 8 * g);
        f32x4 z = (f32x4){0.f, 0.f, 0.f, 0.f};
        z = __builtin_amdgcn_mfma_f32_16x16x32_bf16(kf0, qf0, z, 0, 0, 0);
        s[jt] = __builtin_amdgcn_mfma_f32_16x16x32_bf16(kf1, qf1, z, 0, 0, 0);
    }
    const int qc = 16 * n + r16, win_start = min(max(qc - 8, 0), GRIDW - 16);
    const float* rp = rpb + h * (15 * 31);
    float mx = -3.0e38f;
#pragma unroll
    for (int jt = 0; jt < 16; ++jt) {
        const int drow = row_start + (jt >> 1) - r + 7;
#pragma unroll
        for (int i = 0; i < 4; ++i) {
            const int kc = col_start + 16 * (jt & 1) + 4 * g + i; const bool valid = (kc >= win_start) && (kc < win_start + 16);
            const int dcol = min(max(kc - qc + 15, 0), 30);
            const float v = valid ? s[jt][i] + rp[drow * 31 + dcol] : -1.0e30f;
            s[jt][i] = v; mx = fmaxf(mx, v);
        }
    }
    mx = fmaxf(mx, __shfl_xor(mx, 16)); mx = fmaxf(mx, __shfl_xor(mx, 32));
    float sum = 0.f;
#pragma unroll
    for (int jt = 0; jt < 16; ++jt)
#pragma unroll
        for (int i = 0; i < 4; ++i) { const float p = exp2f((s[jt][i] - mx) * LOG2E); s[jt][i] = p; sum += p; }
    sum += __shfl_xor(sum, 16); sum += __shfl_xor(sum, 32);
    const float inv = 1.0f / sum;
    f32x4 o[4];
#pragma unroll
    for (int dt = 0; dt < 4; ++dt) o[dt] = (f32x4){0.f, 0.f, 0.f, 0.f};
#pragma unroll
    for (int sr = 0; sr < 8; ++sr) {
        u32x4 pw; pw.x = pk2(s[2 * sr][0], s[2 * sr][1]); pw.y = pk2(s[2 * sr][2], s[2 * sr][3]); pw.z = pk2(s[2 * sr + 1][0], s[2 * sr + 1][1]); pw.w = pk2(s[2 * sr + 1][2], s[2 * sr + 1][3]);
        const bf16x8 pa = __builtin_bit_cast(bf16x8, pw);
        const int spos = (row_start + sr) * GRIDW + col_start + 4 * g;
#pragma unroll
        for (int dt = 0; dt < 4; ++dt) {
            const bf16* vp = VT + ((size_t)((b * NH + h) * HD + 16 * dt + r16)) * SEQ + spos;
            const u32x2 lo = *(const u32x2*)vp, hi = *(const u32x2*)(vp + 16);
            u32x4 vw; vw.x = lo.x; vw.y = lo.y; vw.z = hi.x; vw.w = hi.y;
            o[dt] = __builtin_amdgcn_mfma_f32_16x16x32_bf16(pa, __builtin_bit_cast(bf16x8, vw), o[dt], 0, 0, 0);
        }
    }
#pragma unroll
    for (int i = 0; i < 4; ++i) {
        const float iq = __shfl(inv, 4 * g + i);
        bf16* op = ACAT + ((size_t)b * SEQ + r * GRIDW + 16 * n + 4 * g + i) * KCAT + h * HD + r16;
#pragma unroll
        for (int dt = 0; dt < 4; ++dt) op[16 * dt] = (bf16)f2bf(o[dt][i] * iq);
    }
}
__global__ void __launch_bounds__(256) k_attn(bf16* ACAT, const bf16* Kb, const bf16* VT, const float* rpb) {
    const int lane = threadIdx.x & 63, gw = blockIdx.x * 4 + (threadIdx.x >> 6), ngw = gridDim.x * 4;
    for (int u = gw; u < NB * NH * ROWS * 4; u += ngw) {
        const int n = u & 3, r = (u >> 2) & 31, h = (u >> 7) & 7, b = u >> 10;
        attn_unit(b, h, r, n, ACAT, Kb, VT, rpb, lane);
    }
}

template <bool FINAL>
__device__ __forceinline__ void rec_unit(int b, int k, int blk, int cg, const Ptrs& P, int lane) {
    const int r16 = lane & 15, g = lane >> 4;
    const bf16* U = (const bf16*)(P.ws + WS_U); const bf16* WG = (const bf16*)(P.ws + WS_WG); float* CAR = (float*)(P.ws + WS_CAR); bf16* ACAT = (bf16*)(P.ws + WS_ACAT);
    const int t0 = TCH * k, ch = 64 * blk + 16 * cg + r16;
    f32x4 acc[5][4];
#pragma unroll
    for (int ty = 0; ty < 5; ++ty)
#pragma unroll
        for (int m = 0; m < 4; ++m) acc[ty][m] = (f32x4){0.f, 0.f, 0.f, 0.f};
#pragma unroll
    for (int ks = 0; ks < 2; ++ks) {
        const int cin0 = 64 * blk + 32 * ks + 8 * g;
        float cw[4][8], cb[8];
#pragma unroll
        for (int jj = 0; jj < 4; ++jj) { const f32x4 w0 = *(const f32x4*)(P.conv_w + jj * DREC + cin0), w1 = *(const f32x4*)(P.conv_w + jj * DREC + cin0 + 4);
            cw[jj][0] = w0.x; cw[jj][1] = w0.y; cw[jj][2] = w0.z; cw[jj][3] = w0.w; cw[jj][4] = w1.x; cw[jj][5] = w1.y; cw[jj][6] = w1.z; cw[jj][7] = w1.w; }
        { const f32x4 w0 = *(const f32x4*)(P.conv_b + cin0), w1 = *(const f32x4*)(P.conv_b + cin0 + 4);
            cb[0] = w0.x; cb[1] = w0.y; cb[2] = w0.z; cb[3] = w0.w; cb[4] = w1.x; cb[5] = w1.y; cb[6] = w1.z; cb[7] = w1.w; }
        bf16x8 wf[4];
#pragma unroll
        for (int ty = 0; ty < 4; ++ty) wf[ty] = *(const bf16x8*)(WG + ((size_t)((blk * 4 + ty) * 64 + 16 * cg + r16)) * 64 + 32 * ks + 8 * g);
        bf16x8 idf;
#pragma unroll
        for (int j = 0; j < 8; ++j) idf[j] = (32 * ks + 8 * g + j == 16 * cg + r16) ? (short)0x3F80 : (short)0;
#pragma unroll
        for (int m = 0; m < 4; ++m) {
            const int tau = 16 * (r16 >> 2) + 4 * m + (r16 & 3);
            float uc[8];
#pragma unroll
            for (int j = 0; j < 8; ++j) uc[j] = cb[j];
#pragma unroll
            for (int jj = 0; jj < 4; ++jj) {
                const int t = t0 + tau + jj - 2;
                if (t >= 0 && t < SEQ) {
                    const bf16x8 u8 = *(const bf16x8*)(U + ((size_t)b * SEQ + t) * DREC + cin0);
#pragma unroll
                    for (int j = 0; j < 8; ++j) uc[j] += bf2f((unsigned short)u8[j]) * cw[jj][j];
                }
            }
            const bf16x8 af = pack8(uc);
#pragma unroll
            for (int ty = 0; ty < 4; ++ty) acc[ty][m] = __builtin_amdgcn_mfma_f32_16x16x32_bf16(af, wf[ty], acc[ty][m], 0, 0, 0);
            if (ks == (cg >> 1)) acc[4][m] = __builtin_amdgcn_mfma_f32_16x16x32_bf16(af, idf, acc[4][m], 0, 0, 0);
        }
    }
#pragma unroll
    for (int dir = 0; dir < 2; ++dir) {
        const float ba = P.b_rg_a[dir * DREC + ch], bi = P.b_rg_i[dir * DREC + ch], lam = P.lam[dir * DREC + ch];
        const float c2 = -8.0f * log1pf(expf(-lam)) * LOG2E;
#pragma unroll
        for (int m = 0; m < 4; ++m)
#pragma unroll
            for (int i = 0; i < 4; ++i) {
                const float rg = sigmoidf_(acc[2 * dir][m][i] + ba), ig = sigmoidf_(acc[2 * dir + 1][m][i] + bi);
                const float a = exp2f(c2 * rg), mult = sqrtf(fmaxf(1.0f - a * a, 0.f));
                acc[2 * dir][m][i] = a; acc[2 * dir + 1][m][i] = mult * ig * acc[4][m][i];
            }
    }
    float Pf = 1.f, Hf = 0.f, Pb = 1.f, Hb = 0.f;
#pragma unroll
    for (int m = 0; m < 4; ++m)
#pragma unroll
        for (int i = 0; i < 4; ++i) { Hf = acc[0][m][i] * Hf + acc[1][m][i]; Pf *= acc[0][m][i]; }
#pragma unroll
    for (int m = 3; m >= 0; --m)
#pragma unroll
        for (int i = 3; i >= 0; --i) { Hb = acc[2][m][i] * Hb + acc[3][m][i]; Pb *= acc[2][m][i]; }
    float Pfx[4], Hfx[4], Pbx[4], Hbx[4];
#pragma unroll
    for (int x = 0; x < 4; ++x) { Pfx[x] = __shfl(Pf, r16 + 16 * x); Hfx[x] = __shfl(Hf, r16 + 16 * x); Pbx[x] = __shfl(Pb, r16 + 16 * x); Hbx[x] = __shfl(Hb, r16 + 16 * x); }
    float* car = CAR + (size_t)(b * NCHUNK) * 4 * DREC + ch;
    if (!FINAL) {
        float Hc = 0.f, Pc = 1.f;
#pragma unroll
        for (int x = 0; x < 4; ++x) { Hc = Hc * Pfx[x] + Hfx[x]; Pc *= Pfx[x]; }
        float Hd = 0.f, Pd = 1.f;
#pragma unroll
        for (int x = 3; x >= 0; --x) { Hd = Hd * Pbx[x] + Hbx[x]; Pd *= Pbx[x]; }
        if (g == 0) { car[(size_t)(k * 4 + 0) * DREC] = Pc; car[(size_t)(k * 4 + 1) * DREC] = Hc; car[(size_t)(k * 4 + 2) * DREC] = Pd; car[(size_t)(k * 4 + 3) * DREC] = Hd; }
    } else {
        float cf = 0.f, cbk = 0.f;
        for (int j = 0; j < k; ++j) cf = cf * car[(size_t)(j * 4 + 0) * DREC] + car[(size_t)(j * 4 + 1) * DREC];
        for (int j = NCHUNK - 1; j > k; --j) cbk = cbk * car[(size_t)(j * 4 + 2) * DREC] + car[(size_t)(j * 4 + 3) * DREC];
#pragma unroll
        for (int x = 0; x < 4; ++x) if (x < g) cf = cf * Pfx[x] + Hfx[x];
#pragma unroll
        for (int x = 3; x >= 0; --x) if (x > g) cbk = cbk * Pbx[x] + Hbx[x];
        float h = cf;
#pragma unroll
        for (int m = 0; m < 4; ++m)
#pragma unroll
            for (int i = 0; i < 4; ++i) { h = acc[0][m][i] * h + acc[1][m][i]; acc[4][m][i] = h; }
        h = cbk;
#pragma unroll
        for (int m = 3; m >= 0; --m)
#pragma unroll
            for (int i = 3; i >= 0; --i) { h = acc[2][m][i] * h + acc[3][m][i]; acc[4][m][i] += h; }
#pragma unroll
        for (int m = 0; m < 4; ++m)
#pragma unroll
            for (int i = 0; i < 4; ++i) {
                bf16* p = ACAT + ((size_t)b * SEQ + t0 + 16 * g + 4 * m + i) * KCAT + DATT + ch;
                *p = (bf16)f2bf(acc[4][m][i] * bf2f(*p));
            }
    }
}
template <bool FINAL>
__global__ void __launch_bounds__(256) k_rec(Ptrs P) {
    const int lane = threadIdx.x & 63, gw = blockIdx.x * 4 + (threadIdx.x >> 6), ngw = gridDim.x * 4;
    for (int u = gw; u < NB * NCHUNK * 16 * 4; u += ngw) {
        const int cg = u & 3, blk = (u >> 2) & 15, k = (u >> 6) & 31, b = u >> 11;
        rec_unit<FINAL>(b, k, blk, cg, P, lane);
    }
}


template <class Epi>
__device__ __forceinline__ void gemm_simple_phase(const bf16* A, int lda, const bf16* Bt, int ldb, int Mrows, int N, int K, int khook, const Epi& epi, int gw, int ngw, int lane) {
    const int r16 = lane & 15, g = lane >> 4, ntn = N / 64, ntiles = (Mrows / 64) * ntn;
    for (int t = gw; t < ntiles; t += ngw) {
        const int row0 = (t / ntn) * 64, col0 = (t % ntn) * 64;
        f32x4 acc[4][4];
#pragma unroll
        for (int m = 0; m < 4; ++m)
#pragma unroll
            for (int n = 0; n < 4; ++n) acc[m][n] = (f32x4){0.f, 0.f, 0.f, 0.f};
        const bf16* ap = A + (size_t)(row0 + r16) * lda + 8 * g;
        const bf16* bp = Bt + (size_t)(col0 + r16) * ldb + 8 * g;
        for (int k0 = 0; k0 < K; k0 += 32) {
            if (k0 == khook) {
#pragma unroll
                for (int m = 0; m < 4; ++m)
#pragma unroll
                    for (int n = 0; n < 4; ++n)
#pragma unroll
                        for (int i = 0; i < 4; ++i) acc[m][n][i] *= epi.hook(row0 + 16 * m + 4 * g + i, col0 + 16 * n + r16);
            }
            bf16x8 a[4], b[4];
#pragma unroll
            for (int m = 0; m < 4; ++m) a[m] = *(const bf16x8*)(ap + (size_t)(16 * m) * lda + k0);
#pragma unroll
            for (int n = 0; n < 4; ++n) b[n] = *(const bf16x8*)(bp + (size_t)(16 * n) * ldb + k0);
#pragma unroll
            for (int m = 0; m < 4; ++m)
#pragma unroll
                for (int n = 0; n < 4; ++n) acc[m][n] = __builtin_amdgcn_mfma_f32_16x16x32_bf16(a[m], b[n], acc[m][n], 0, 0, 0);
        }
#pragma unroll
        for (int m = 0; m < 4; ++m)
#pragma unroll
            for (int n = 0; n < 4; ++n)
#pragma unroll
                for (int i = 0; i < 4; ++i) epi(row0 + 16 * m + 4 * g + i, col0 + 16 * n + r16, acc[m][n][i]);
    }
}

#define GAS __attribute__((address_space(1)))
#define LAS __attribute__((address_space(3)))
#define XB_TMO      128
#define XB_XCNT(j)  (256  + 64 * (j))
#define XB_XSUB(j)  (1280 + 64 * (j))
#define XB_XGEN(j)  (2304 + 64 * (j))
#define XB_TOP      3328
#define XB_TOPGEN   3392
#define XCD_BAR_WORDS 3456
#define XB_SPIN_CAP (1u << 18)
__device__ __forceinline__ unsigned xb_ld(unsigned* p)              { return __hip_atomic_load(p, __ATOMIC_RELAXED, __HIP_MEMORY_SCOPE_AGENT); }
__device__ __forceinline__ unsigned xb_add(unsigned* p, unsigned v) { return __hip_atomic_fetch_add(p, v, __ATOMIC_RELAXED, __HIP_MEMORY_SCOPE_AGENT); }
__device__ __forceinline__ unsigned xb_xcc_id() { return (unsigned)__builtin_amdgcn_s_getreg((3 << 11) | 20) & 0xFu; }
#define XB_SPIN(cond, bar) do { unsigned _sp = 0; while (cond) { __builtin_amdgcn_s_sleep(1); \
    if ((++_sp & 255u) == 0u) { if (xb_ld(&(bar)[XB_TMO])) break; if (_sp > XB_SPIN_CAP) { atomicAdd(&(bar)[XB_TMO], 1u); break; } } } } while (0)
struct XcdBarrier { unsigned* bar; unsigned x; volatile LAS unsigned* st; };
__device__ __forceinline__ XcdBarrier xcd_barrier_post(unsigned* bar, volatile LAS unsigned* st) {
    XcdBarrier b; b.bar = bar; b.x = xb_xcc_id(); b.st = st;
    if (threadIdx.x == 0) (void)xb_add(&bar[XB_XCNT(b.x)], 1u);
    return b;
}
__device__ __forceinline__ void xcd_barrier_complete(unsigned* bar, unsigned x, unsigned& nloc, unsigned& nx) {
    const unsigned G = gridDim.x * gridDim.y * gridDim.z;
    unsigned sum, cnt, mine, sp = 0u;
    for (;;) {
        sum = 0u; cnt = 0u; mine = 0u;
#pragma unroll
        for (unsigned j = 0; j < 16; ++j) { const unsigned c = xb_ld(&bar[XB_XCNT(j)]); sum += c; cnt += (c > 0u) ? 1u : 0u; mine = (j == x) ? c : mine; }
        if (sum == G) break;
        __builtin_amdgcn_s_sleep(1);
        if ((++sp & 255u) == 0u) { if (xb_ld(&bar[XB_TMO])) break; if (sp > XB_SPIN_CAP) { atomicAdd(&bar[XB_TMO], 1u); break; } }
    }
    nloc = mine > 0u ? mine : 1u; nx = cnt > 0u ? cnt : 1u;
}
__device__ __forceinline__ void xcd_barrier(const XcdBarrier& b) {
    asm volatile("s_waitcnt vmcnt(0)" ::: "memory");
    __syncthreads();
    if (threadIdx.x == 0) {
        unsigned* bar = b.bar;
        __builtin_amdgcn_s_waitcnt(0);
        unsigned nloc = b.st[0], nx = b.st[1];
        if (nloc == 0u) { xcd_barrier_complete(bar, b.x, nloc, nx); b.st[0] = nloc; b.st[1] = nx; }
        const unsigned old = xb_add(&bar[XB_XSUB(b.x)], 1u);
        const unsigned gen = old / nloc;
        if (old + 1u == (gen + 1u) * nloc) {
            __builtin_amdgcn_fence(__ATOMIC_RELEASE, "agent");
            asm volatile("s_waitcnt vmcnt(0)" ::: "memory");
            const unsigned og = xb_add(&bar[XB_TOP], 1u);
            const unsigned tg = og / nx;
            if (og + 1u == (tg + 1u) * nx) xb_add(&bar[XB_TOPGEN], 1u);
            else XB_SPIN(xb_ld(&bar[XB_TOPGEN]) == tg, bar);
            __builtin_amdgcn_fence(__ATOMIC_ACQUIRE, "agent");
            xb_add(&bar[XB_XGEN(b.x)], 1u);
            asm volatile("s_waitcnt vmcnt(0)" ::: "memory");
        } else {
            XB_SPIN(xb_ld(&bar[XB_XGEN(b.x)]) == gen, bar);
            __builtin_amdgcn_fence(__ATOMIC_ACQUIRE, "agent");
            asm volatile("s_waitcnt vmcnt(0)" ::: "memory");
        }
    }
    __syncthreads();
}

constexpr int NWAVES = 8;
constexpr int RING_OFF = 0, RING_BYTES = 131072, LDSCTL_OFF = RING_BYTES, MISC_OFF = LDSCTL_OFF + 320, LDS_BYTES = 147456;
constexpr int CW_BAR = 4096;
constexpr size_t CTL_ZERO_BYTES = 64 * 1024;

__global__ void __launch_bounds__(NWAVES * 64, 2) mega_fwd(Ptrs P) {
    extern __shared__ __attribute__((aligned(16))) unsigned char lds[];
    const int tid = threadIdx.x, lane = tid & 63, wave = __builtin_amdgcn_readfirstlane(tid >> 6);
    const int G = gridDim.x, bx = blockIdx.x, vcu = (G % 8 == 0) ? (bx % 8) * (G / 8) + bx / 8 : bx;
    const int gw = vcu * NWAVES + wave, ngw = G * NWAVES;
    for (int u = tid; u < (LDS_BYTES - LDSCTL_OFF) / 4; u += NWAVES * 64) ((LAS unsigned*)((LAS unsigned char*)lds + LDSCTL_OFF))[u] = 0u;
    __syncthreads();
    unsigned char* ws = P.ws;
    XcdBarrier bar = xcd_barrier_post((unsigned*)(ws + WS_CTL) + CW_BAR, (volatile LAS unsigned*)((LAS unsigned char*)lds + MISC_OFF) + 8);
    bf16 *XN = (bf16*)(ws + WS_XN), *WIN = (bf16*)(ws + WS_WIN), *ACAT = (bf16*)(ws + WS_ACAT), *Kb = (bf16*)(ws + WS_K), *VT = (bf16*)(ws + WS_VT), *U = (bf16*)(ws + WS_U);
    bf16 *RATIO = (bf16*)(ws + WS_RATIO), *SR = (bf16*)(ws + WS_SR), *WCAT = (bf16*)(ws + WS_WCAT), *MIXED = (bf16*)(ws + WS_MIXED), *WOUT = (bf16*)(ws + WS_WOUT);
    bf16 *X1B = (bf16*)(ws + WS_X1B), *WFF1 = (bf16*)(ws + WS_WFF1), *WFF2 = (bf16*)(ws + WS_WFF2), *HFF = (bf16*)(ws + WS_HFF);
    float* SS1 = (float*)(ws + WS_SS1);

    p0_prologue(P, (float*)(lds + RING_OFF + wave * 16384), gw, ngw, lane);
    xcd_barrier(bar);
    gemm_simple_phase(XN, D, WIN, D, M, DIN, D, -1, EpiP1s{P.b_in, ACAT, Kb, VT, U, RATIO, SR}, gw, ngw, lane);
    xcd_barrier(bar);
    for (size_t i = (size_t)gw * 64 + lane; i < (size_t)M * D; i += (size_t)ngw * 64) RATIO[i] = (bf16)f2bf(bf2f(RATIO[i]) / bf2f(SR[i]));
    for (int u = gw; u < NB * NH * ROWS * 4; u += ngw) attn_unit(u >> 10, (u >> 7) & 7, (u >> 2) & 31, u & 3, ACAT, Kb, VT, P.rpb, lane);
    for (int u = gw; u < NB * NCHUNK * 16 * 4; u += ngw) rec_unit<false>(u >> 11, (u >> 6) & 31, (u >> 2) & 15, u & 3, P, lane);
    xcd_barrier(bar);
    for (int u = gw; u < NB * NCHUNK * 16 * 4; u += ngw) rec_unit<true>(u >> 11, (u >> 6) & 31, (u >> 2) & 15, u & 3, P, lane);
    xcd_barrier(bar);
    gemm_simple_phase(ACAT, KCAT, WCAT, KCAT, M, D, KCAT, DATT, EpiP3s{RATIO, SR, MIXED}, gw, ngw, lane);
    xcd_barrier(bar);
    gemm_simple_phase(MIXED, D, WOUT, D, M, D, D, -1, EpiP4s{P.x, P.out, X1B}, gw, ngw, lane);
    xcd_barrier(bar);
    for (int m = gw; m < M; m += ngw) {
        const f32x4* xr = (const f32x4*)(P.out + (size_t)m * D) + lane; float s = 0.f;
#pragma unroll
        for (int j = 0; j < 4; ++j) { const f32x4 v = xr[64 * j]; s += (v.x * v.x + v.y * v.y) + (v.z * v.z + v.w * v.w); }
        s = wave_sum(s);
        if (lane < 4) SS1[(size_t)m * 4 + lane] = lane == 0 ? s : 0.f;
    }
    xcd_barrier(bar);
    gemm_simple_phase(X1B, D, WFF1, D, M, DFF, D, -1, EpiP5s{SS1, HFF}, gw, ngw, lane);
    xcd_barrier(bar);
    gemm_simple_phase(HFF, DFF, WFF2, DFF, M, D, DFF, -1, EpiP6s{P.out}, gw, ngw, lane);
    xcd_barrier(bar);
    for (int m = gw; m < M; m += ngw) {
        f32x4* xr = (f32x4*)(P.out + (size_t)m * D) + lane; f32x4 v[4]; float s = 0.f;
#pragma unroll
        for (int j = 0; j < 4; ++j) { v[j] = xr[64 * j]; s += (v[j].x * v[j].x + v[j].y * v[j].y) + (v[j].z * v[j].z + v[j].w * v[j].w); }
        const float rstd = 1.0f / sqrtf(wave_sum(s) * (1.0f / D) + EPS);
#pragma unroll
        for (int j = 0; j < 4; ++j) { const f32x4 gg = ((const f32x4*)P.lnf_g)[lane + 64 * j]; xr[64 * j] = v[j] * rstd * gg; }
    }
}

extern "C" void kernel_launch(void* const* d_in, const int* in_sizes, int n_in, void* d_out, int out_size, void* d_ws, size_t ws_size, hipStream_t stream) {
    static int grid = 0;
    if (grid == 0) {
        if (n_in != 19 || out_size != M * D || ws_size < WS_END) { fprintf(stderr, "kernel_launch: unexpected shapes (n_in %d out %d ws %zu)\n", n_in, out_size, ws_size); grid = -1; return; }
        int dev = 0, cus = 0, per_cu = 0;
        if (hipGetDevice(&dev) != hipSuccess || hipDeviceGetAttribute(&cus, hipDeviceAttributeMultiprocessorCount, dev) != hipSuccess) { grid = -1; return; }
        if (hipFuncSetAttribute((const void*)mega_fwd, hipFuncAttributeMaxDynamicSharedMemorySize, LDS_BYTES) != hipSuccess) { fprintf(stderr, "kernel_launch: hipFuncSetAttribute failed\n"); grid = -1; return; }
        if (hipOccupancyMaxActiveBlocksPerMultiprocessor(&per_cu, (const void*)mega_fwd, NWAVES * 64, LDS_BYTES) != hipSuccess || per_cu < 1) { fprintf(stderr, "kernel_launch: occupancy query says %d blocks/CU\n", per_cu); per_cu = 1; }
        (void)hipGetLastError();
        grid = cus;
    }
    if (grid < 0) return;
    Ptrs P{};
    const float** pf = (const float**)&P;
    for (int i = 0; i < 19; ++i) pf[i] = (const float*)d_in[i];
    P.out = (float*)d_out; P.ws = (unsigned char*)d_ws;
    (void)hipMemsetAsync((char*)d_ws + WS_CTL, 0, CTL_ZERO_BYTES, stream);
    hipLaunchKernelGGL(mega_fwd, dim3(grid), dim3(NWAVES * 64), LDS_BYTES, stream, P);
}
```

```cpp
#include <hip/hip_runtime.h>
#include <cstdint>
#include <cstdio>

typedef unsigned short bf16;
typedef short bf16x8 __attribute__((ext_vector_type(8)));
typedef short bf16x4 __attribute__((ext_vector_type(4)));
typedef float f32x4 __attribute__((ext_vector_type(4)));
typedef unsigned u32x4 __attribute__((ext_vector_type(4)));
typedef unsigned u32x2 __attribute__((ext_vector_type(2)));

constexpr int NB = 8, SEQ = 2048, D = 1024, M = NB * SEQ;
constexpr int DATT = 512, NH = 8, HD = 64, DREC = 1024, DIN = 5632, DFF = 4096;
constexpr int GRIDW = 64, ROWS = 32;
constexpr int KCAT = DATT + DREC;
constexpr int NCHUNK = 32, TCH = 64;
constexpr float EPS = 1e-6f;
constexpr float LOG2E = 1.4426950408889634f;

constexpr size_t MiB = 1u << 20;
constexpr size_t WS_CTL = 0;
constexpr size_t WS_CAR = 1 * MiB;
constexpr size_t WS_SS1 = 5 * MiB;
constexpr size_t WS_SS2 = 6 * MiB;
constexpr size_t WS_WG = 7 * MiB;
constexpr size_t WS_PAR = 7 * MiB + 512 * 1024;
constexpr int PB_BIN = 0, PB_RPB = 5632, PB_CW = PB_RPB + 3720 + 8, PB_CB = PB_CW + 4096, PB_BA = PB_CB + 1024, PB_BI = PB_BA + 2048, PB_C2 = PB_BI + 2048, PB_GF = PB_C2 + 2048, PB_END = PB_GF + 1024;
constexpr size_t WS_WIN = 8 * MiB;
constexpr size_t WS_WCAT = 19 * MiB;
constexpr size_t WS_WOUT = 22 * MiB;
constexpr size_t WS_WFF1 = 24 * MiB;
constexpr size_t WS_WFF2 = 32 * MiB;
constexpr size_t WS_XN = 40 * MiB;
constexpr size_t WS_MIXED = 40 * MiB;
constexpr size_t WS_U = 72 * MiB;
constexpr size_t WS_X1B = 72 * MiB;
constexpr size_t WS_ACAT = 104 * MiB;
constexpr size_t WS_K = 152 * MiB;
constexpr size_t WS_VT = 168 * MiB;
constexpr size_t WS_RATIO = 184 * MiB;
constexpr size_t WS_SR = 216 * MiB;
constexpr size_t WS_HFF = 104 * MiB;
constexpr size_t WS_END = 248 * MiB;

__device__ __forceinline__ unsigned f2bf(float f) { unsigned u = __builtin_bit_cast(unsigned, f); return (u + 0x7fffu + ((u >> 16) & 1u)) >> 16; }
__device__ __forceinline__ float bf2f(unsigned short h) { return __builtin_bit_cast(float, ((unsigned)h) << 16); }
__device__ __forceinline__ unsigned pk2(float lo, float hi) { return f2bf(lo) | (f2bf(hi) << 16); }
__device__ __forceinline__ float sigmoidf_(float x) { return 1.0f / (1.0f + exp2f(-x * LOG2E)); }
__device__ __forceinline__ float gelu_tanh(float x) { const float z = 1.5957691216057308f * (x + 0.044715f * x * x * x); return x * sigmoidf_(z); }
__device__ __forceinline__ float wave_sum(float v) {
#pragma unroll
    for (int o = 1; o < 64; o <<= 1) v += __shfl_xor(v, o);
    return v;
}
__device__ __forceinline__ bf16x8 pack8(const float* v) {
    u32x4 w; w.x = pk2(v[0], v[1]); w.y = pk2(v[2], v[3]); w.z = pk2(v[4], v[5]); w.w = pk2(v[6], v[7]);
    return __builtin_bit_cast(bf16x8, w);
}

__device__ __forceinline__ void transpose_item(const float* W, int N, int k0, int n0, bf16* dst, int dpitch, int drow0, int dcol0,
                                               const float* kscale, float* scr, int lane) {
#pragma unroll 8
    for (int i = 0; i < 32; ++i) {
        const int kk = 2 * i + (lane >> 5);
        float v = W[(size_t)(k0 + kk) * N + n0 + (lane & 31)];
        if (kscale) v *= kscale[k0 + kk];
        scr[kk * 33 + (lane & 31)] = v;
    }
    __builtin_amdgcn_s_waitcnt(0xc07f);
    asm volatile("" ::: "memory");
    const int c = lane & 7;
#pragma unroll
    for (int j = 0; j < 4; ++j) {
        const int n = (lane >> 3) + 8 * j; const float* s = scr + (8 * c) * 33 + n;
        u32x4 o; o.x = pk2(s[0 * 33], s[1 * 33]); o.y = pk2(s[2 * 33], s[3 * 33]); o.z = pk2(s[4 * 33], s[5 * 33]); o.w = pk2(s[6 * 33], s[7 * 33]);
        *(u32x4*)(dst + (size_t)(drow0 + n0 + n) * dpitch + dcol0 + k0 + 8 * c) = o;
    }
    __builtin_amdgcn_s_waitcnt(0xc07f);
    asm volatile("" ::: "memory");
}

struct Ptrs {
    const float *x, *ln1_g, *w_in, *b_in, *rpb, *w_att_o, *conv_w, *conv_b, *w_rg_a, *b_rg_a, *w_rg_i, *b_rg_i, *lam, *w_rec_o, *w_out, *ln2_g, *w_ff1, *w_ff2, *lnf_g;
    float* out; unsigned char* ws;
};

__device__ __forceinline__ int win_dest_row(int n0) {
    if (n0 < 3584) return n0;
    if (n0 < 4608) { const int c = n0 - 3584; return 3584 + 256 * (c >> 7) + (c & 127); }
    const int c = n0 - 4608; return 3584 + 256 * (c >> 7) + 128 + (c & 127);
}

__device__ __forceinline__ void p0_prologue(const Ptrs& P, float* scr, int gw, int ngw, int lane) {
    bf16* WIN = (bf16*)(P.ws + WS_WIN); bf16* WCAT = (bf16*)(P.ws + WS_WCAT); bf16* WOUT = (bf16*)(P.ws + WS_WOUT);
    bf16* WFF1 = (bf16*)(P.ws + WS_WFF1); bf16* WFF2 = (bf16*)(P.ws + WS_WFF2); bf16* WG = (bf16*)(P.ws + WS_WG);
    constexpr int I_IN = 16 * 176, I_AO = 8 * 32, I_RO = 16 * 32, I_OUT = 16 * 32, I_F1 = 16 * 128, I_F2 = 64 * 32, I_G = 128;
    constexpr int NITEMS = I_IN + I_AO + I_RO + I_OUT + I_F1 + I_F2 + I_G;
    for (int it = gw; it < NITEMS; it += ngw) {
        int r = it;
        if (r < I_IN) { const int kb = r / 176, nb = r % 176; transpose_item(P.w_in, DIN, 64 * kb, 32 * nb, WIN, D, win_dest_row(32 * nb) - 32 * nb, 0, nullptr, scr, lane); continue; } r -= I_IN;
        if (r < I_AO) { const int kb = r / 32, nb = r % 32; transpose_item(P.w_att_o, D, 64 * kb, 32 * nb, WCAT, KCAT, 0, 0, nullptr, scr, lane); continue; } r -= I_AO;
        if (r < I_RO) { const int kb = r / 32, nb = r % 32; transpose_item(P.w_rec_o, D, 64 * kb, 32 * nb, WCAT, KCAT, 0, DATT, nullptr, scr, lane); continue; } r -= I_RO;
        if (r < I_OUT) { const int kb = r / 32, nb = r % 32; transpose_item(P.w_out, D, 64 * kb, 32 * nb, WOUT, D, 0, 0, nullptr, scr, lane); continue; } r -= I_OUT;
        if (r < I_F1) { const int kb = r / 128, nb = r % 128; transpose_item(P.w_ff1, DFF, 64 * kb, 32 * nb, WFF1, D, 0, 0, P.ln2_g, scr, lane); continue; } r -= I_F1;
        if (r < I_F2) { const int kb = r / 32, nb = r % 32; transpose_item(P.w_ff2, D, 64 * kb, 32 * nb, WFF2, DFF, 0, 0, nullptr, scr, lane); continue; } r -= I_F2;
        {
            const int mi = r >> 1, nb = r & 1, blk = mi >> 2, ty = mi & 3, dir = ty >> 1;
            const float* src = ((ty & 1) ? P.w_rg_i : P.w_rg_a) + (size_t)(dir * 16 + blk) * 4096;
            transpose_item(src, 64, 0, 32 * nb, WG + (size_t)mi * 4096, 64, 0, 0, nullptr, scr, lane);
        }
    }
    {
        float* PB = (float*)(P.ws + WS_PAR); const int gt = gw * 64 + lane, ngt = ngw * 64;
        for (int i = gt; i < 5632; i += ngt) PB[PB_BIN + i] = P.b_in[i];
        for (int i = gt; i < 3720; i += ngt) PB[PB_RPB + i] = P.rpb[i];
        for (int i = gt; i < 4096; i += ngt) PB[PB_CW + i] = P.conv_w[i];
        for (int i = gt; i < 1024; i += ngt) PB[PB_CB + i] = P.conv_b[i];
        for (int i = gt; i < 2048; i += ngt) PB[PB_BA + i] = P.b_rg_a[i];
        for (int i = gt; i < 2048; i += ngt) PB[PB_BI + i] = P.b_rg_i[i];
        for (int i = gt; i < 2048; i += ngt) PB[PB_C2 + i] = -8.0f * log1pf(expf(-P.lam[i])) * LOG2E;
        for (int i = gt; i < 1024; i += ngt) PB[PB_GF + i] = P.lnf_g[i];
    }
    bf16* XN = (bf16*)(P.ws + WS_XN);
    for (int m = gw; m < M; m += ngw) {
        const f32x4* xr = (const f32x4*)(P.x + (size_t)m * D) + lane;
        f32x4 v[4]; float s = 0.f;
#pragma unroll
        for (int j = 0; j < 4; ++j) { v[j] = xr[64 * j]; s += (v[j].x * v[j].x + v[j].y * v[j].y) + (v[j].z * v[j].z + v[j].w * v[j].w); }
        const float rstd = 1.0f / sqrtf(wave_sum(s) * (1.0f / D) + EPS);
        u32x2* o8 = (u32x2*)(XN + (size_t)m * D) + lane;
#pragma unroll
        for (int j = 0; j < 4; ++j) { const f32x4 g = ((const f32x4*)P.ln1_g)[lane + 64 * j];
            u32x2 w; w.x = pk2(v[j].x * rstd * g.x, v[j].y * rstd * g.y); w.y = pk2(v[j].z * rstd * g.z, v[j].w * rstd * g.w); o8[64 * j] = w; }
    }
}

__global__ void __launch_bounds__(256) k_prologue(Ptrs P) {
    __shared__ float scr_all[4][64 * 33];
    const int lane = threadIdx.x & 63, wave = threadIdx.x >> 6;
    p0_prologue(P, scr_all[wave], blockIdx.x * 4 + wave, gridDim.x * 4, lane);
}

template <class Epi>
__global__ void __launch_bounds__(256) k_gemm_simple(const bf16* A, int lda, const bf16* Bt, int ldb, int K, int khook, Epi epi) {
    const int lane = threadIdx.x & 63, wave = threadIdx.x >> 6, r16 = lane & 15, g = lane >> 4;
    const int row0 = blockIdx.y * 128 + (wave >> 1) * 64, col0 = blockIdx.x * 128 + (wave & 1) * 64;
    f32x4 acc[4][4];
#pragma unroll
    for (int m = 0; m < 4; ++m)
#pragma unroll
        for (int n = 0; n < 4; ++n) acc[m][n] = (f32x4){0.f, 0.f, 0.f, 0.f};
    const bf16* ap = A + (size_t)(row0 + r16) * lda + 8 * g;
    const bf16* bp = Bt + (size_t)(col0 + r16) * ldb + 8 * g;
    for (int k0 = 0; k0 < K; k0 += 32) {
        if (k0 == khook) {
#pragma unroll
            for (int m = 0; m < 4; ++m)
#pragma unroll
                for (int n = 0; n < 4; ++n)
#pragma unroll
                    for (int i = 0; i < 4; ++i) acc[m][n][i] *= epi.hook(row0 + 16 * m + 4 * g + i, col0 + 16 * n + r16);
        }
        bf16x8 a[4], b[4];
#pragma unroll
        for (int m = 0; m < 4; ++m) a[m] = *(const bf16x8*)(ap + (size_t)(16 * m) * lda + k0);
#pragma unroll
        for (int n = 0; n < 4; ++n) b[n] = *(const bf16x8*)(bp + (size_t)(16 * n) * ldb + k0);
#pragma unroll
        for (int m = 0; m < 4; ++m)
#pragma unroll
            for (int n = 0; n < 4; ++n) acc[m][n] = __builtin_amdgcn_mfma_f32_16x16x32_bf16(a[m], b[n], acc[m][n], 0, 0, 0);
    }
#pragma unroll
    for (int m = 0; m < 4; ++m)
#pragma unroll
        for (int n = 0; n < 4; ++n)
#pragma unroll
            for (int i = 0; i < 4; ++i) epi(row0 + 16 * m + 4 * g + i, col0 + 16 * n + r16, acc[m][n][i]);
}

struct EpiP1s {
    const float* b_in; bf16 *ACAT, *Kb, *VT, *U, *RATIO, *SR;
    __device__ __forceinline__ float hook(int, int) const { return 1.f; }
    __device__ __forceinline__ void operator()(int row, int col, float v) const {
        if (col < 3584) {
            v += b_in[col];
            if (col < 512) ACAT[(size_t)row * KCAT + col] = (bf16)f2bf(v * 0.125f);
            else if (col < 1024) Kb[(size_t)row * DATT + (col - 512)] = (bf16)f2bf(v);
            else if (col < 1536) { const int c = col - 1024, h = c >> 6, d = c & 63, b = row >> 11, s = row & 2047; VT[((size_t)((b * NH + h) * HD + d)) * SEQ + s] = (bf16)f2bf(v); }
            else if (col < 2560) U[(size_t)row * DREC + (col - 1536)] = (bf16)f2bf(v);
            else ACAT[(size_t)row * KCAT + DATT + (col - 2560)] = (bf16)f2bf(gelu_tanh(v));
        } else {
            const int j = (col - 3584) >> 8, w = (col - 3584) & 255, isrec = w >> 7, ch = 128 * j + (w & 127);
            v += b_in[(isrec ? 4608 : 3584) + ch];
            (isrec ? SR : RATIO)[(size_t)row * D + ch] = (bf16)f2bf(sigmoidf_(v));
        }
    }
};
__global__ void k_ratio(bf16* RATIO, const bf16* SR, size_t n) {
    for (size_t i = (size_t)blockIdx.x * blockDim.x + threadIdx.x; i < n; i += (size_t)gridDim.x * blockDim.x) RATIO[i] = (bf16)f2bf(bf2f(RATIO[i]) / bf2f(SR[i]));
}
struct EpiP3s {
    const bf16 *RATIO, *SR; bf16* MIXED;
    __device__ __forceinline__ float hook(int row, int col) const { return bf2f(RATIO[(size_t)row * D + col]); }
    __device__ __forceinline__ void operator()(int row, int col, float v) const { MIXED[(size_t)row * D + col] = (bf16)f2bf(v * bf2f(SR[(size_t)row * D + col])); }
};
struct EpiP4s {
    const float* x; float* X1; bf16* X1B;
    __device__ __forceinline__ float hook(int, int) const { return 1.f; }
    __device__ __forceinline__ void operator()(int row, int col, float v) const { const float r = x[(size_t)row * D + col] + v; X1[(size_t)row * D + col] = r; X1B[(size_t)row * D + col] = (bf16)f2bf(r); }
};
struct EpiP5s {
    const float* SS1; bf16* HFF;
    __device__ __forceinline__ float hook(int, int) const { return 1.f; }
    __device__ __forceinline__ void operator()(int row, int col, float v) const {
        const f32x4 s = *(const f32x4*)(SS1 + (size_t)row * 4); const float r2 = 1.0f / (((s.x + s.y) + (s.z + s.w)) * (1.0f / D) + EPS);
        const float t = v > 0.f ? v : 0.f; HFF[(size_t)row * DFF + col] = (bf16)f2bf(t * t * r2);
    }
};
struct EpiP6s {
    float* X;
    __device__ __forceinline__ float hook(int, int) const { return 1.f; }
    __device__ __forceinline__ void operator()(int row, int col, float v) const { X[(size_t)row * D + col] += v; }
};
__global__ void __launch_bounds__(256) k_rowss(const float* X, float* SS) {
    const int lane = threadIdx.x & 63, gw = blockIdx.x * 4 + (threadIdx.x >> 6), ngw = gridDim.x * 4;
    for (int m = gw; m < M; m += ngw) {
        const f32x4* xr = (const f32x4*)(X + (size_t)m * D) + lane; float s = 0.f;
#pragma unroll
        for (int j = 0; j < 4; ++j) { const f32x4 v = xr[64 * j]; s += (v.x * v.x + v.y * v.y) + (v.z * v.z + v.w * v.w); }
        s = wave_sum(s);
        if (lane < 4) SS[(size_t)m * 4 + lane] = lane == 0 ? s : 0.f;
    }
}
__global__ void __launch_bounds__(256) k_final(float* X, const float* g) {
    const int lane = threadIdx.x & 63, gw = blockIdx.x * 4 + (threadIdx.x >> 6), ngw = gridDim.x * 4;
    for (int m = gw; m < M; m += ngw) {
        f32x4* xr = (f32x4*)(X + (size_t)m * D) + lane; f32x4 v[4]; float s = 0.f;
#pragma unroll
        for (int j = 0; j < 4; ++j) { v[j] = xr[64 * j]; s += (v[j].x * v[j].x + v[j].y * v[j].y) + (v[j].z * v[j].z + v[j].w * v[j].w); }
        const float rstd = 1.0f / sqrtf(wave_sum(s) * (1.0f / D) + EPS);
#pragma unroll
        for (int j = 0; j < 4; ++j) { const f32x4 gg = ((const f32x4*)g)[lane + 64 * j]; xr[64 * j] = v[j] * rstd * gg; }
    }
}

__device__ __forceinline__ void attn_unit(int b, int h, int r, int n, bf16* ACAT, const bf16* Kb, const bf16* VT, const float* rpb, int lane) {
    const int r16 = lane & 15, g = lane >> 4;
    const int row_start = min(max(r - 4, 0), ROWS - 8), col_start = min(max(16 * n - 8, 0), GRIDW - 32);
    const size_t tokq = (size_t)b * SEQ + r * GRIDW + 16 * n + r16;
    const bf16x8 qf0 = *(const bf16x8*)(ACAT + tokq * KCAT + h * HD + 8 * g);
    const bf16x8 qf1 = *(const bf16x8*)(ACAT + tokq * KCAT + h * HD + 32 + 8 * g);
    f32x4 s[16];
#pragma unroll
    for (int jt = 0; jt < 16; ++jt) {
        const size_t tokk = (size_t)b * SEQ + (row_start + (jt >> 1)) * GRIDW + col_start + 16 * (jt & 1) + r16;
        const bf16x8 kf0 = *(const bf16x8*)(Kb + tokk * DATT + h * HD + 8 * g);
        const bf16x8 kf1 = *(const bf16x8*)(Kb + tokk * DATT + h * HD + 32 + 8 * g);
        f32x4 z = (f32x4){0.f, 0.f, 0.f, 0.f};
        z = __builtin_amdgcn_mfma_f32_16x16x32_bf16(kf0, qf0, z, 0, 0, 0);
        s[jt] = __builtin_amdgcn_mfma_f32_16x16x32_bf16(kf1, qf1, z, 0, 0, 0);
    }
    const int qc = 16 * n + r16, win_start = min(max(qc - 8, 0), GRIDW - 16);
    const float* rp = rpb + h * (15 * 31);
    float mx = -3.0e38f;
#pragma unroll
    for (int jt = 0; jt < 16; ++jt) {
        const int drow = row_start + (jt >> 1) - r + 7;
#pragma unroll
        for (int i = 0; i < 4; ++i) {
            const int kc = col_start + 16 * (jt & 1) + 4 * g + i; const bool valid = (kc >= win_start) && (kc < win_start + 16);
            const int dcol = min(max(kc - qc + 15, 0), 30);
            const float v = valid ? s[jt][i] + rp[drow * 31 + dcol] : -1.0e30f;
            s[jt][i] = v; mx = fmaxf(mx, v);
        }
    }
    mx = fmaxf(mx, __shfl_xor(mx, 16)); mx = fmaxf(mx, __shfl_xor(mx, 32));
    float sum = 0.f;
#pragma unroll
    for (int jt = 0; jt < 16; ++jt)
#pragma unroll
        for (int i = 0; i < 4; ++i) { const float p = exp2f((s[jt][i] - mx) * LOG2E); s[jt][i] = p; sum += p; }
    sum += __shfl_xor(sum, 16); sum += __shfl_xor(sum, 32);
    const float inv = 1.0f / sum;
    f32x4 o[4];
#pragma unroll
    for (int dt = 0; dt < 4; ++dt) o[dt] = (f32x4){0.f, 0.f, 0.f, 0.f};
#pragma unroll
    for (int sr = 0; sr < 8; ++sr) {
        u32x4 pw; pw.x = pk2(s[2 * sr][0], s[2 * sr][1]); pw.y = pk2(s[2 * sr][2], s[2 * sr][3]); pw.z = pk2(s[2 * sr + 1][0], s[2 * sr + 1][1]); pw.w = pk2(s[2 * sr + 1][2], s[2 * sr + 1][3]);
        const bf16x8 pa = __builtin_bit_cast(bf16x8, pw);
        const int spos = (row_start + sr) * GRIDW + col_start + 4 * g;
#pragma unroll
        for (int dt = 0; dt < 4; ++dt) {
            const bf16* vp = VT + ((size_t)((b * NH + h) * HD + 16 * dt + r16)) * SEQ + spos;
            const u32x2 lo = *(const u32x2*)vp, hi = *(const u32x2*)(vp + 16);
            u32x4 vw; vw.x = lo.x; vw.y = lo.y; vw.z = hi.x; vw.w = hi.y;
            o[dt] = __builtin_amdgcn_mfma_f32_16x16x32_bf16(pa, __builtin_bit_cast(bf16x8, vw), o[dt], 0, 0, 0);
        }
    }
#pragma unroll
    for (int i = 0; i < 4; ++i) {
        const float iq = __shfl(inv, 4 * g + i);
        bf16* op = ACAT + ((size_t)b * SEQ + r * GRIDW + 16 * n + 4 * g + i) * KCAT + h * HD + r16;
#pragma unroll
        for (int dt = 0; dt < 4; ++dt) op[16 * dt] = (bf16)f2bf(o[dt][i] * iq);
    }
}
__global__ void __launch_bounds__(256) k_attn(bf16* ACAT, const bf16* Kb, const bf16* VT, const float* rpb) {
    const int lane = threadIdx.x & 63, gw = blockIdx.x * 4 + (threadIdx.x >> 6), ngw = gridDim.x * 4;
    for (int u = gw; u < NB * NH * ROWS * 4; u += ngw) {
        const int n = u & 3, r = (u >> 2) & 31, h = (u >> 7) & 7, b = u >> 10;
        attn_unit(b, h, r, n, ACAT, Kb, VT, rpb, lane);
    }
}

template <bool FINAL>
__device__ __forceinline__ void rec_unit(int b, int k, int blk, int cg, unsigned char* ws, int lane) {
    const int r16 = lane & 15, g = lane >> 4;
    const bf16* U = (const bf16*)(ws + WS_U); const bf16* WG = (const bf16*)(ws + WS_WG); float* CAR = (float*)(ws + WS_CAR); bf16* ACAT = (bf16*)(ws + WS_ACAT); const float* PB = (const float*)(ws + WS_PAR);
    const int t0 = TCH * k, ch = 64 * blk + 16 * cg + r16;
    f32x4 acc[5][4];
#pragma unroll
    for (int ty = 0; ty < 5; ++ty)
#pragma unroll
        for (int m = 0; m < 4; ++m) acc[ty][m] = (f32x4){0.f, 0.f, 0.f, 0.f};
#pragma unroll
    for (int ks = 0; ks < 2; ++ks) {
        const int cin0 = 64 * blk + 32 * ks + 8 * g;
        float cw[4][8], cb[8];
#pragma unroll
        for (int jj = 0; jj < 4; ++jj) { const f32x4 w0 = *(const f32x4*)(PB + PB_CW + jj * DREC + cin0), w1 = *(const f32x4*)(PB + PB_CW + jj * DREC + cin0 + 4);
            cw[jj][0] = w0.x; cw[jj][1] = w0.y; cw[jj][2] = w0.z; cw[jj][3] = w0.w; cw[jj][4] = w1.x; cw[jj][5] = w1.y; cw[jj][6] = w1.z; cw[jj][7] = w1.w; }
        { const f32x4 w0 = *(const f32x4*)(PB + PB_CB + cin0), w1 = *(const f32x4*)(PB + PB_CB + cin0 + 4);
            cb[0] = w0.x; cb[1] = w0.y; cb[2] = w0.z; cb[3] = w0.w; cb[4] = w1.x; cb[5] = w1.y; cb[6] = w1.z; cb[7] = w1.w; }
        bf16x8 wf[4];
#pragma unroll
        for (int ty = 0; ty < 4; ++ty) wf[ty] = *(const bf16x8*)(WG + ((size_t)((blk * 4 + ty) * 64 + 16 * cg + r16)) * 64 + 32 * ks + 8 * g);
        bf16x8 idf;
#pragma unroll
        for (int j = 0; j < 8; ++j) idf[j] = (32 * ks + 8 * g + j == 16 * cg + r16) ? (short)0x3F80 : (short)0;
#pragma unroll
        for (int m = 0; m < 4; ++m) {
            const int tau = 16 * (r16 >> 2) + 4 * m + (r16 & 3);
            float uc[8];
#pragma unroll
            for (int j = 0; j < 8; ++j) uc[j] = cb[j];
#pragma unroll
            for (int jj = 0; jj < 4; ++jj) {
                const int t = t0 + tau + jj - 2;
                if (t >= 0 && t < SEQ) {
                    const bf16x8 u8 = *(const bf16x8*)(U + ((size_t)b * SEQ + t) * DREC + cin0);
#pragma unroll
                    for (int j = 0; j < 8; ++j) uc[j] += bf2f((unsigned short)u8[j]) * cw[jj][j];
                }
            }
            const bf16x8 af = pack8(uc);
#pragma unroll
            for (int ty = 0; ty < 4; ++ty) acc[ty][m] = __builtin_amdgcn_mfma_f32_16x16x32_bf16(af, wf[ty], acc[ty][m], 0, 0, 0);
            if (ks == (cg >> 1)) acc[4][m] = __builtin_amdgcn_mfma_f32_16x16x32_bf16(af, idf, acc[4][m], 0, 0, 0);
            asm volatile("" ::: "memory");
        }
    }
#pragma unroll
    for (int dir = 0; dir < 2; ++dir) {
        const float ba = PB[PB_BA + dir * DREC + ch], bi = PB[PB_BI + dir * DREC + ch], c2 = PB[PB_C2 + dir * DREC + ch];
#pragma unroll
        for (int m = 0; m < 4; ++m)
#pragma unroll
            for (int i = 0; i < 4; ++i) {
                const float rg = sigmoidf_(acc[2 * dir][m][i] + ba), ig = sigmoidf_(acc[2 * dir + 1][m][i] + bi);
                const float a = exp2f(c2 * rg), mult = sqrtf(fmaxf(1.0f - a * a, 0.f));
                acc[2 * dir][m][i] = a; acc[2 * dir + 1][m][i] = mult * ig * acc[4][m][i];
            }
    }
    float Pf = 1.f, Hf = 0.f, Pb = 1.f, Hb = 0.f;
#pragma unroll
    for (int m = 0; m < 4; ++m)
#pragma unroll
        for (int i = 0; i < 4; ++i) { Hf = acc[0][m][i] * Hf + acc[1][m][i]; Pf *= acc[0][m][i]; }
#pragma unroll
    for (int m = 3; m >= 0; --m)
#pragma unroll
        for (int i = 3; i >= 0; --i) { Hb = acc[2][m][i] * Hb + acc[3][m][i]; Pb *= acc[2][m][i]; }
    float Pfx[4], Hfx[4], Pbx[4], Hbx[4];
#pragma unroll
    for (int x = 0; x < 4; ++x) { Pfx[x] = __shfl(Pf, r16 + 16 * x); Hfx[x] = __shfl(Hf, r16 + 16 * x); Pbx[x] = __shfl(Pb, r16 + 16 * x); Hbx[x] = __shfl(Hb, r16 + 16 * x); }
    float* car = CAR + (size_t)(b * NCHUNK) * 4 * DREC + ch;
    if (!FINAL) {
        float Hc = 0.f, Pc = 1.f;
#pragma unroll
        for (int x = 0; x < 4; ++x) { Hc = Hc * Pfx[x] + Hfx[x]; Pc *= Pfx[x]; }
        float Hd = 0.f, Pd = 1.f;
#pragma unroll
        for (int x = 3; x >= 0; --x) { Hd = Hd * Pbx[x] + Hbx[x]; Pd *= Pbx[x]; }
        if (g == 0) { car[(size_t)(k * 4 + 0) * DREC] = Pc; car[(size_t)(k * 4 + 1) * DREC] = Hc; car[(size_t)(k * 4 + 2) * DREC] = Pd; car[(size_t)(k * 4 + 3) * DREC] = Hd; }
    } else {
        float cf = 0.f, cbk = 0.f;
        for (int j = 0; j < k; ++j) cf = cf * car[(size_t)(j * 4 + 0) * DREC] + car[(size_t)(j * 4 + 1) * DREC];
        for (int j = NCHUNK - 1; j > k; --j) cbk = cbk * car[(size_t)(j * 4 + 2) * DREC] + car[(size_t)(j * 4 + 3) * DREC];
#pragma unroll
        for (int x = 0; x < 4; ++x) if (x < g) cf = cf * Pfx[x] + Hfx[x];
#pragma unroll
        for (int x = 3; x >= 0; --x) if (x > g) cbk = cbk * Pbx[x] + Hbx[x];
        float h = cf;
#pragma unroll
        for (int m = 0; m < 4; ++m)
#pragma unroll
            for (int i = 0; i < 4; ++i) { h = acc[0][m][i] * h + acc[1][m][i]; acc[4][m][i] = h; }
        h = cbk;
#pragma unroll
        for (int m = 3; m >= 0; --m)
#pragma unroll
            for (int i = 3; i >= 0; --i) { h = acc[2][m][i] * h + acc[3][m][i]; acc[4][m][i] += h; }
#pragma unroll
        for (int m = 0; m < 4; ++m)
#pragma unroll
            for (int i = 0; i < 4; ++i) {
                bf16* p = ACAT + ((size_t)b * SEQ + t0 + 16 * g + 4 * m + i) * KCAT + DATT + ch;
                *p = (bf16)f2bf(acc[4][m][i] * bf2f(*p));
            }
    }
}
template <bool FINAL>
__global__ void __launch_bounds__(256) k_rec(Ptrs P) {
    const int lane = threadIdx.x & 63, gw = blockIdx.x * 4 + (threadIdx.x >> 6), ngw = gridDim.x * 4;
    for (int u = gw; u < NB * NCHUNK * 16 * 4; u += ngw) {
        const int cg = u & 3, blk = (u >> 2) & 15, k = (u >> 6) & 31, b = u >> 11;
        rec_unit<FINAL>(b, k, blk, cg, P.ws, lane);
    }
}


template <class Epi>
__device__ __forceinline__ void gemm_simple_phase(const bf16* A, int lda, const bf16* Bt, int ldb, int Mrows, int N, int K, int khook, const Epi& epi, int gw, int ngw, int lane) {
    const int r16 = lane & 15, g = lane >> 4, ntn = N / 64, ntiles = (Mrows / 64) * ntn;
    for (int t = gw; t < ntiles; t += ngw) {
        const int row0 = (t / ntn) * 64, col0 = (t % ntn) * 64;
        f32x4 acc[4][4];
#pragma unroll
        for (int m = 0; m < 4; ++m)
#pragma unroll
            for (int n = 0; n < 4; ++n) acc[m][n] = (f32x4){0.f, 0.f, 0.f, 0.f};
        const bf16* ap = A + (size_t)(row0 + r16) * lda + 8 * g;
        const bf16* bp = Bt + (size_t)(col0 + r16) * ldb + 8 * g;
        for (int k0 = 0; k0 < K; k0 += 32) {
            if (k0 == khook) {
#pragma unroll
                for (int m = 0; m < 4; ++m)
#pragma unroll
                    for (int n = 0; n < 4; ++n)
#pragma unroll
                        for (int i = 0; i < 4; ++i) acc[m][n][i] *= epi.hook(row0 + 16 * m + 4 * g + i, col0 + 16 * n + r16);
            }
            bf16x8 a[4], b[4];
#pragma unroll
            for (int m = 0; m < 4; ++m) a[m] = *(const bf16x8*)(ap + (size_t)(16 * m) * lda + k0);
#pragma unroll
            for (int n = 0; n < 4; ++n) b[n] = *(const bf16x8*)(bp + (size_t)(16 * n) * ldb + k0);
#pragma unroll
            for (int m = 0; m < 4; ++m)
#pragma unroll
                for (int n = 0; n < 4; ++n) acc[m][n] = __builtin_amdgcn_mfma_f32_16x16x32_bf16(a[m], b[n], acc[m][n], 0, 0, 0);
        }
#pragma unroll
        for (int m = 0; m < 4; ++m)
#pragma unroll
            for (int n = 0; n < 4; ++n)
#pragma unroll
                for (int i = 0; i < 4; ++i) epi(row0 + 16 * m + 4 * g + i, col0 + 16 * n + r16, acc[m][n][i]);
    }
}

namespace pg8 {
#define PG8_LAS __attribute__((address_space(3)))
typedef unsigned short bf16_t;
typedef short bf16x8 __attribute__((ext_vector_type(8)));
typedef float f32x4 __attribute__((ext_vector_type(4)));
typedef unsigned u32x4 __attribute__((ext_vector_type(4)));
constexpr int BM = 256, BK = 64, HALF = 128, HTB = HALF * BK * 2  , STAGE_BYTES = 8 * HTB, NXCD = 8, WGM = 8;

__host__ __device__ __forceinline__ int lds_byte(int r, int c) { const int st = (r >> 4) * 2 + (c >> 5), rr = r & 15, cc = c & 31, ob = rr * 64 + cc * 2; return st * 1024 + (ob ^ (((ob >> 9) & 1) << 5)); }
__host__ __device__ __forceinline__ void stage_rc(int b, int& R, int& C) { const int st = b / 1024, sb = b % 1024, swz = sb ^ (((sb >> 9) & 1) << 5); R = (st >> 1) * 16 + swz / 64; C = (st & 1) * 32 + (swz % 64) / 2; }
__host__ __device__ __forceinline__ int perm32(int rho) { const int n = rho >> 4, i = rho & 15; return 8 * (i >> 2) + 4 * n + (i & 3); }

struct Unit { int pm, pn; };
struct Gemm { const bf16_t* A; const bf16_t* Bt; int M, N, K; };

struct StaticOrder {
    int nM, nN, nwg, G, c;
    __host__ __device__ void init(int M, int N, int G_, int c_) { nM = M / BM; nN = N / BM; nwg = nM * nN; G = G_; c = c_; }
    __host__ __device__ bool next(int i, Unit& u) const {
        const long L = (long)i * G + c; if (L >= nwg) return false;
        int wgid = (int)L; { const int q = nwg / NXCD, r = nwg % NXCD, xcd = wgid % NXCD, off = wgid / NXCD; wgid = (xcd < r ? xcd * (q + 1) : r * (q + 1) + (xcd - r) * q) + off; }
        const int nig = WGM * nN, gid = wgid / nig, fm = gid * WGM, gsz = (nM - fm) < WGM ? (nM - fm) : WGM;
        u.pm = fm + ((wgid % nig) % gsz); u.pn = (wgid % nig) / gsz; return true;
    }
    __device__ __forceinline__ void a_ready(const Unit&) const {}
    __device__ __forceinline__ void done(const Unit&) const {}
};

__device__ __forceinline__ unsigned cvt_pk_bf16(float lo, float hi) { unsigned r; asm volatile("v_cvt_pk_bf16_f32 %0, %1, %2" : "=v"(r) : "v"(lo), "v"(hi)); return r; }

__device__ __forceinline__ float ex2(float x) { return __builtin_amdgcn_exp2f(x); }
__device__ __forceinline__ float rcp(float x) { return __builtin_amdgcn_rcpf(x); }
__device__ __forceinline__ float sigm(float x) { return rcp(1.0f + ex2(x * -1.4426950408889634f)); }
__device__ __forceinline__ float gelu_t(float x) { return x * sigm(1.5957691216057308f * (x + 0.044715f * x * x * x)); }
__device__ __forceinline__ u32x4 pack8(const f32x4 a, const f32x4 b) { u32x4 w; w.x = cvt_pk_bf16(a[0], a[1]); w.y = cvt_pk_bf16(a[2], a[3]); w.z = cvt_pk_bf16(b[0], b[1]); w.w = cvt_pk_bf16(b[2], b[3]); return w; }
__device__ __forceinline__ void unpack8(const u32x4 w, f32x4& a, f32x4& b) {
    a[0] = __builtin_bit_cast(float, w.x << 16); a[1] = __builtin_bit_cast(float, w.x & 0xffff0000u); a[2] = __builtin_bit_cast(float, w.y << 16); a[3] = __builtin_bit_cast(float, w.y & 0xffff0000u);
    b[0] = __builtin_bit_cast(float, w.z << 16); b[1] = __builtin_bit_cast(float, w.z & 0xffff0000u); b[2] = __builtin_bit_cast(float, w.w << 16); b[3] = __builtin_bit_cast(float, w.w & 0xffff0000u); }

struct EpiP1 {
    static constexpr bool PERM = true, AFTER_DRAIN = false, HOOK = false; static constexpr int HOOK_T = -1;
    const float* b_in; bf16_t *ACAT, *Kb, *VT, *U, *RATIO, *SR;
    __device__ __forceinline__ void hook(f32x4 (&)[2][2][4][2], const Unit&, int, int, int, int) const {}
    __device__ __forceinline__ void operator()(const f32x4 (&acc)[2][2][4][2], const Unit& u, int wr, int wc, int fr, int fq) const {
        const int pn = u.pn, row0 = u.pm * BM + wr * 64 + fr, cw = wc * 32 + 8 * fq;
        if (pn < 14) {
            const int colb = pn * BM + cw;
            f32x4 bv[2][2];
#pragma unroll
            for (int bj = 0; bj < 2; ++bj)
#pragma unroll
                for (int n = 0; n < 2; ++n) bv[bj][n] = *(const f32x4*)(b_in + colb + bj * HALF + 4 * n);
            if (pn < 2) {
#pragma unroll
                for (int ai = 0; ai < 2; ++ai)
#pragma unroll
                    for (int m = 0; m < 4; ++m) { bf16_t* rp = ACAT + (size_t)(row0 + ai * HALF + m * 16) * 1536 + colb;
#pragma unroll
                        for (int bj = 0; bj < 2; ++bj) *(u32x4*)(rp + bj * HALF) = pack8((acc[ai][bj][m][0] + bv[bj][0]) * 0.125f, (acc[ai][bj][m][1] + bv[bj][1]) * 0.125f); }
            } else if (pn < 4) {
#pragma unroll
                for (int ai = 0; ai < 2; ++ai)
#pragma unroll
                    for (int m = 0; m < 4; ++m) { bf16_t* rp = Kb + (size_t)(row0 + ai * HALF + m * 16) * 512 + (colb - 512);
#pragma unroll
                        for (int bj = 0; bj < 2; ++bj) *(u32x4*)(rp + bj * HALF) = pack8(acc[ai][bj][m][0] + bv[bj][0], acc[ai][bj][m][1] + bv[bj][1]); }
            } else if (pn < 6) {
#pragma unroll
                for (int ai = 0; ai < 2; ++ai)
#pragma unroll
                    for (int m = 0; m < 4; ++m) { const int row = row0 + ai * HALF + m * 16, bq = row >> 11, s = row & 2047;
#pragma unroll
                        for (int bj = 0; bj < 2; ++bj) { const int cc = colb + bj * HALF - 1024; const u32x4 w = pack8(acc[ai][bj][m][0] + bv[bj][0], acc[ai][bj][m][1] + bv[bj][1]);
                            bf16_t* vp = VT + ((size_t)(bq * 512 + cc)) * 2048 + s;
                            vp[0 * 2048] = (bf16_t)(w.x & 0xffffu); vp[1 * 2048] = (bf16_t)(w.x >> 16); vp[2 * 2048] = (bf16_t)(w.y & 0xffffu); vp[3 * 2048] = (bf16_t)(w.y >> 16);
                            vp[4 * 2048] = (bf16_t)(w.z & 0xffffu); vp[5 * 2048] = (bf16_t)(w.z >> 16); vp[6 * 2048] = (bf16_t)(w.w & 0xffffu); vp[7 * 2048] = (bf16_t)(w.w >> 16); } }
            } else if (pn < 10) {
#pragma unroll
                for (int ai = 0; ai < 2; ++ai)
#pragma unroll
                    for (int m = 0; m < 4; ++m) { bf16_t* rp = U + (size_t)(row0 + ai * HALF + m * 16) * 1024 + (colb - 1536);
#pragma unroll
                        for (int bj = 0; bj < 2; ++bj) *(u32x4*)(rp + bj * HALF) = pack8(acc[ai][bj][m][0] + bv[bj][0], acc[ai][bj][m][1] + bv[bj][1]); }
            } else {
#pragma unroll
                for (int ai = 0; ai < 2; ++ai)
#pragma unroll
                    for (int m = 0; m < 4; ++m) { bf16_t* rp = ACAT + (size_t)(row0 + ai * HALF + m * 16) * 1536 + 512 + (colb - 2560);
#pragma unroll
                        for (int bj = 0; bj < 2; ++bj) { f32x4 v0 = acc[ai][bj][m][0] + bv[bj][0], v1 = acc[ai][bj][m][1] + bv[bj][1];
#pragma unroll
                            for (int e = 0; e < 4; ++e) { v0[e] = gelu_t(v0[e]); v1[e] = gelu_t(v1[e]); }
                            *(u32x4*)(rp + bj * HALF) = pack8(v0, v1); } }
            }
        } else {
            const int ch0 = (pn - 14) * HALF + cw;
            f32x4 ba[2], br[2];
#pragma unroll
            for (int n = 0; n < 2; ++n) { ba[n] = *(const f32x4*)(b_in + 3584 + ch0 + 4 * n); br[n] = *(const f32x4*)(b_in + 4608 + ch0 + 4 * n); }
#pragma unroll
            for (int ai = 0; ai < 2; ++ai)
#pragma unroll
                for (int m = 0; m < 4; ++m) { const size_t off = (size_t)(row0 + ai * HALF + m * 16) * 1024 + ch0; f32x4 rt[2], sr[2];
#pragma unroll
                    for (int n = 0; n < 2; ++n) { const f32x4 ga = acc[ai][0][m][n] + ba[n], gr = acc[ai][1][m][n] + br[n];
#pragma unroll
                        for (int e = 0; e < 4; ++e) { const float ea = 1.0f + ex2(ga[e] * -1.4426950408889634f), er = 1.0f + ex2(gr[e] * -1.4426950408889634f); sr[n][e] = rcp(er); rt[n][e] = er * rcp(ea); } }
                    *(u32x4*)(RATIO + off) = pack8(rt[0], rt[1]); *(u32x4*)(SR + off) = pack8(sr[0], sr[1]); }
        }
    }
};
struct EpiP3 {
    static constexpr bool PERM = true, AFTER_DRAIN = false, HOOK = true; static constexpr int HOOK_T = 8;
    const bf16_t *RATIO, *SR; bf16_t* MIXED;
    __device__ __forceinline__ void hook(f32x4 (&acc)[2][2][4][2], const Unit& u, int wr, int wc, int fr, int fq) const {
        unsigned o = (unsigned)((u.pm * BM + wr * 64 + fr) * 1024 + u.pn * BM + wc * 32 + 8 * fq);
        asm volatile("" : "+v"(o));
        const bf16_t* rp = RATIO + o;
#pragma unroll
        for (int ai = 0; ai < 2; ++ai)
#pragma unroll
            for (int m = 0; m < 4; ++m) {
#pragma unroll
                for (int bj = 0; bj < 2; ++bj) { f32x4 f0, f1; unpack8(*(const u32x4*)(rp + (ai * HALF + m * 16) * 1024 + bj * HALF), f0, f1); acc[ai][bj][m][0] *= f0; acc[ai][bj][m][1] *= f1; }
                if (m & 1) asm volatile("" ::: "memory"); }
    }
    __device__ __forceinline__ void operator()(const f32x4 (&acc)[2][2][4][2], const Unit& u, int wr, int wc, int fr, int fq) const {
        const int row0 = u.pm * BM + wr * 64 + fr, colb = u.pn * BM + wc * 32 + 8 * fq;
#pragma unroll
        for (int ai = 0; ai < 2; ++ai)
#pragma unroll
            for (int m = 0; m < 4; ++m)
#pragma unroll
                for (int bj = 0; bj < 2; ++bj) { const size_t off = (size_t)(row0 + ai * HALF + m * 16) * 1024 + colb + bj * HALF; f32x4 f0, f1; unpack8(*(const u32x4*)(SR + off), f0, f1);
                    *(u32x4*)(MIXED + off) = pack8(acc[ai][bj][m][0] * f0, acc[ai][bj][m][1] * f1); }
    }
};
struct EpiP4 {
    static constexpr bool PERM = true, AFTER_DRAIN = false, HOOK = false; static constexpr int HOOK_T = -1;
    const float* x; float* X1; bf16_t* X1B; float* SS;
    __device__ __forceinline__ void hook(f32x4 (&)[2][2][4][2], const Unit&, int, int, int, int) const {}
    __device__ __forceinline__ void operator()(const f32x4 (&acc)[2][2][4][2], const Unit& u, int wr, int wc, int fr, int fq) const {
        const int row0 = u.pm * BM + wr * 64 + fr, colb = u.pn * BM + wc * 32 + 8 * fq;
#pragma unroll
        for (int ai = 0; ai < 2; ++ai)
#pragma unroll
            for (int m = 0; m < 4; ++m) { const int row = row0 + ai * HALF + m * 16; float ss = 0.f;
#pragma unroll
                for (int bj = 0; bj < 2; ++bj) { const size_t off = (size_t)row * 1024 + colb + bj * HALF;
                    const f32x4 r0 = *(const f32x4*)(x + off) + acc[ai][bj][m][0], r1 = *(const f32x4*)(x + off + 4) + acc[ai][bj][m][1];
                    *(f32x4*)(X1 + off) = r0; *(f32x4*)(X1 + off + 4) = r1; *(u32x4*)(X1B + off) = pack8(r0, r1);
                    ss += (r0[0] * r0[0] + r0[1] * r0[1]) + (r0[2] * r0[2] + r0[3] * r0[3]) + (r1[0] * r1[0] + r1[1] * r1[1]) + (r1[2] * r1[2] + r1[3] * r1[3]); }
                ss += __shfl_xor(ss, 16); ss += __shfl_xor(ss, 32);
                if (fq == 0) SS[(size_t)row * 16 + u.pn * 4 + wc] = ss; }
    }
};
struct EpiP5 {
    static constexpr bool PERM = true, AFTER_DRAIN = false, HOOK = false; static constexpr int HOOK_T = -1;
    const float* SS; bf16_t* HFF;
    __device__ __forceinline__ void hook(f32x4 (&)[2][2][4][2], const Unit&, int, int, int, int) const {}
    __device__ __forceinline__ void operator()(const f32x4 (&acc)[2][2][4][2], const Unit& u, int wr, int wc, int fr, int fq) const {
        const int row0 = u.pm * BM + wr * 64 + fr, colb = u.pn * BM + wc * 32 + 8 * fq;
#pragma unroll
        for (int ai = 0; ai < 2; ++ai)
#pragma unroll
            for (int m = 0; m < 4; ++m) { const int row = row0 + ai * HALF + m * 16; const f32x4* sp = (const f32x4*)(SS + (size_t)row * 16);
                const f32x4 s0 = sp[0], s1 = sp[1], s2 = sp[2], s3 = sp[3];
                const float tot = ((s0[0] + s0[1]) + (s0[2] + s0[3])) + ((s1[0] + s1[1]) + (s1[2] + s1[3])) + ((s2[0] + s2[1]) + (s2[2] + s2[3])) + ((s3[0] + s3[1]) + (s3[2] + s3[3]));
                const float r2 = 1.0f / (tot * (1.0f / 1024.0f) + 1e-6f);
#pragma unroll
                for (int bj = 0; bj < 2; ++bj) { f32x4 v0 = acc[ai][bj][m][0], v1 = acc[ai][bj][m][1];
#pragma unroll
                    for (int e = 0; e < 4; ++e) { const float a = fmaxf(v0[e], 0.f), b = fmaxf(v1[e], 0.f); v0[e] = a * a * r2; v1[e] = b * b * r2; }
                    *(u32x4*)(HFF + (size_t)row * 4096 + colb + bj * HALF) = pack8(v0, v1); } }
    }
};
struct EpiP6 {
    static constexpr bool PERM = true, AFTER_DRAIN = false, HOOK = false; static constexpr int HOOK_T = -1;
    float* X; float* SS;
    __device__ __forceinline__ void hook(f32x4 (&)[2][2][4][2], const Unit&, int, int, int, int) const {}
    __device__ __forceinline__ void operator()(const f32x4 (&acc)[2][2][4][2], const Unit& u, int wr, int wc, int fr, int fq) const {
        const int row0 = u.pm * BM + wr * 64 + fr, colb = u.pn * BM + wc * 32 + 8 * fq;
#pragma unroll
        for (int ai = 0; ai < 2; ++ai)
#pragma unroll
            for (int m = 0; m < 4; ++m) { const int row = row0 + ai * HALF + m * 16; float ss = 0.f;
#pragma unroll
                for (int bj = 0; bj < 2; ++bj) { const size_t off = (size_t)row * 1024 + colb + bj * HALF;
                    const f32x4 r0 = *(const f32x4*)(X + off) + acc[ai][bj][m][0], r1 = *(const f32x4*)(X + off + 4) + acc[ai][bj][m][1];
                    *(f32x4*)(X + off) = r0; *(f32x4*)(X + off + 4) = r1;
                    ss += (r0[0] * r0[0] + r0[1] * r0[1]) + (r0[2] * r0[2] + r0[3] * r0[3]) + (r1[0] * r1[0] + r1[1] * r1[1]) + (r1[2] * r1[2] + r1[3] * r1[3]); }
                ss += __shfl_xor(ss, 16); ss += __shfl_xor(ss, 32);
                if (fq == 0) SS[(size_t)row * 16 + u.pn * 4 + wc] = ss; }
    }
};

template <class Epi, class Sched, bool ALIGN_EPI = false, bool SP2 = false>
__device__ __forceinline__ void gemm_phase(PG8_LAS unsigned char* lds, const Gemm g, const Sched& S, const Epi& E) {
    const int tid = threadIdx.x, wid = __builtin_amdgcn_readfirstlane(tid >> 6), lane = tid & 63, wr = wid >> 2, wc = wid & 3, fr = lane & 15, fq = lane >> 4;
    const int K = g.K, nt = K / BK;
    unsigned voffA[2], voffB[2];
#pragma unroll
    for (int i = 0; i < 2; ++i) { int R, C; stage_rc(tid * 16 + i * 8192, R, C); const int Rb = Epi::PERM ? ((R & ~31) + perm32(R & 31)) : R;
        voffA[i] = (unsigned)(R * K + C) * 2u; voffB[i] = (unsigned)(Rb * K + C) * 2u; }
    const size_t kstep = (size_t)(BK * 2);
    const size_t hstep = (size_t)HALF * K * 2;
    const size_t tstep = 2 * hstep;
    const unsigned ldsw = (unsigned)wid * 1024u;
    const int aoff = lds_byte(wr * 64 + fr, fq * 8), boff = lds_byte(wc * 32 + fr, fq * 8);
#define PG8_SA(b, h) (((b) * 2 + (h)) * HTB)
#define PG8_SB(b, h) ((4 + (b) * 2 + (h)) * HTB)
#define PG8_STAGE(bufoff, gbase, voff) do { _Pragma("unroll") for (int _i = 0; _i < 2; ++_i) \
        __builtin_amdgcn_global_load_lds((const unsigned*)((const char*)(gbase) + (voff)[_i]), (PG8_LAS unsigned*)(lds + (bufoff) + ldsw + _i * 8192), 16, 0, 0); } while (0)
#define PG8_LDA(dst, b, h) do { _Pragma("unroll") for (int m = 0; m < 4; ++m) _Pragma("unroll") for (int k = 0; k < 2; ++k) dst[m][k] = *(const PG8_LAS bf16x8*)(lds + PG8_SA(b, h) + aoff + m * 2048 + k * 1024); } while (0)
#define PG8_LDB(dst, b, h) do { _Pragma("unroll") for (int n = 0; n < 2; ++n) _Pragma("unroll") for (int k = 0; k < 2; ++k) dst[n][k] = *(const PG8_LAS bf16x8*)(lds + PG8_SB(b, h) + boff + n * 2048 + k * 1024); } while (0)
#define PG8_MMA(ai, bj, At, Bt) do { __builtin_amdgcn_s_setprio(1); _Pragma("unroll") for (int m = 0; m < 4; ++m) _Pragma("unroll") for (int n = 0; n < 2; ++n) _Pragma("unroll") for (int k = 0; k < 2; ++k) \
        acc[ai][bj][m][n] = __builtin_amdgcn_mfma_f32_16x16x32_bf16(Bt[n][k], At[m][k], acc[ai][bj][m][n], 0, 0, 0); __builtin_amdgcn_s_setprio(0); } while (0)
#define PG8_WAIT_V(n) asm volatile("s_waitcnt vmcnt(" #n ")" ::: "memory")
#define PG8_WAIT_L(n) asm volatile("s_waitcnt lgkmcnt(" #n ")" ::: "memory")
#define PG8_BAR __builtin_amdgcn_s_barrier()
#define PG8_SCHED __builtin_amdgcn_sched_barrier(0)
    Unit cur, nxt; int ui = 0;
    if (!S.next(0, cur)) return;
    f32x4 acc[2][2][4][2];
#pragma unroll
    for (int a = 0; a < 2; ++a)
#pragma unroll
        for (int b = 0; b < 2; ++b)
#pragma unroll
            for (int m = 0; m < 4; ++m)
#pragma unroll
                for (int n = 0; n < 2; ++n) acc[a][b][m][n] = (f32x4){0.f, 0.f, 0.f, 0.f};
    bf16x8 At[4][2], B0[2][2], B1[2][2];
    const char* cA = (const char*)g.A + (size_t)cur.pm * tstep; const char* cB = (const char*)g.Bt + (size_t)cur.pn * tstep;
    S.a_ready(cur);
    if constexpr (SP2) {
        PG8_STAGE(PG8_SB(0, 0), cB, voffB); PG8_STAGE(PG8_SB(0, 1), cB + hstep, voffB); PG8_STAGE(PG8_SA(0, 0), cA, voffA); PG8_STAGE(PG8_SA(0, 1), cA + hstep, voffA);
        if (wr == 1) PG8_BAR;
        PG8_WAIT_V(2); PG8_BAR;
        PG8_STAGE(PG8_SB(1, 0), cB + kstep, voffB); PG8_STAGE(PG8_SA(1, 0), cA + kstep, voffA); PG8_STAGE(PG8_SB(1, 1), cB + hstep + kstep, voffB);
        PG8_WAIT_V(6); PG8_BAR;
    } else {
        PG8_STAGE(PG8_SB(0, 0), cB, voffB); PG8_STAGE(PG8_SA(0, 0), cA, voffA); PG8_STAGE(PG8_SB(0, 1), cB + hstep, voffB); PG8_STAGE(PG8_SA(0, 1), cA + hstep, voffA);
        if (wr == 1) PG8_BAR;
        PG8_WAIT_V(4); PG8_BAR;
        PG8_STAGE(PG8_SB(1, 0), cB + kstep, voffB); PG8_STAGE(PG8_SA(1, 0), cA + kstep, voffA); PG8_STAGE(PG8_SB(1, 1), cB + hstep + kstep, voffB);
        PG8_WAIT_V(6); PG8_BAR;
    }
    for (;;) {
        const bool has_next = S.next(ui + 1, nxt);
        const char* nA = has_next ? (const char*)g.A + (size_t)nxt.pm * tstep : cA; const char* nB = has_next ? (const char*)g.Bt + (size_t)nxt.pn * tstep : cB;
        for (int t = 0; t < nt; t += 2) {
            if constexpr (Epi::HOOK) { if (t == Epi::HOOK_T) E.hook(acc, cur, wr, wc, fr, fq); }
            const bool last = (t == nt - 2);
            const char* a1 = cA + (size_t)(t + 1) * kstep;
            const char* a2 = last ? nA : cA + (size_t)(t + 2) * kstep; const char* b2 = last ? nB : cB + (size_t)(t + 2) * kstep;
            const char* a3 = a2 + kstep; const char* b3 = b2 + kstep;
            if (last && has_next) S.a_ready(nxt);
            if constexpr (SP2) {
            PG8_LDB(B0, 0, 0); PG8_LDB(B1, 0, 1); PG8_SCHED; PG8_LDA(At, 0, 0); PG8_STAGE(PG8_SA(1, 1), a1 + hstep, voffA);
            PG8_WAIT_V(8); PG8_WAIT_L(0); PG8_BAR; PG8_MMA(0, 0, At, B0); PG8_MMA(0, 1, At, B1); PG8_BAR; PG8_SCHED;
            PG8_LDA(At, 0, 1); PG8_STAGE(PG8_SB(0, 0), b2, voffB); PG8_STAGE(PG8_SB(0, 1), b2 + hstep, voffB); PG8_STAGE(PG8_SA(0, 0), a2, voffA);
            PG8_WAIT_V(8); PG8_WAIT_L(0); PG8_BAR; PG8_MMA(1, 0, At, B0); PG8_MMA(1, 1, At, B1); PG8_BAR; PG8_SCHED;
            PG8_LDB(B0, 1, 0); PG8_LDB(B1, 1, 1); PG8_SCHED; PG8_LDA(At, 1, 0); PG8_STAGE(PG8_SA(0, 1), a2 + hstep, voffA);
            PG8_WAIT_V(8); PG8_WAIT_L(0); PG8_BAR; PG8_MMA(0, 0, At, B0); PG8_MMA(0, 1, At, B1); PG8_BAR; PG8_SCHED;
            PG8_LDA(At, 1, 1); PG8_STAGE(PG8_SB(1, 0), b3, voffB); PG8_STAGE(PG8_SB(1, 1), b3 + hstep, voffB); PG8_STAGE(PG8_SA(1, 0), a3, voffA);
            PG8_WAIT_V(8); PG8_WAIT_L(0); PG8_BAR; PG8_MMA(1, 0, At, B0); PG8_MMA(1, 1, At, B1); PG8_BAR; PG8_SCHED;
            } else {
            PG8_LDB(B0, 0, 0); PG8_SCHED; PG8_LDA(At, 0, 0); PG8_STAGE(PG8_SA(1, 1), a1 + hstep, voffA);
            PG8_WAIT_L(8); PG8_BAR; PG8_WAIT_L(0); PG8_MMA(0, 0, At, B0); PG8_BAR; PG8_SCHED;
            PG8_LDB(B1, 0, 1); PG8_STAGE(PG8_SB(0, 0), b2, voffB);
            PG8_BAR; PG8_WAIT_L(0); PG8_MMA(0, 1, At, B1); PG8_BAR;
            PG8_LDA(At, 0, 1); PG8_STAGE(PG8_SA(0, 0), a2, voffA);
            PG8_BAR; PG8_WAIT_L(0); PG8_MMA(1, 0, At, B0); PG8_BAR; PG8_SCHED;
            PG8_STAGE(PG8_SB(0, 1), b2 + hstep, voffB);
            PG8_WAIT_V(6); PG8_BAR; PG8_MMA(1, 1, At, B1); PG8_BAR;
            PG8_LDB(B0, 1, 0); PG8_SCHED; PG8_LDA(At, 1, 0); PG8_STAGE(PG8_SA(0, 1), a2 + hstep, voffA);
            PG8_WAIT_L(8); PG8_BAR; PG8_WAIT_L(0); PG8_MMA(0, 0, At, B0); PG8_BAR; PG8_SCHED;
            PG8_LDB(B1, 1, 1); PG8_STAGE(PG8_SB(1, 0), b3, voffB);
            PG8_BAR; PG8_WAIT_L(0); PG8_MMA(0, 1, At, B1); PG8_BAR;
            PG8_LDA(At, 1, 1); PG8_STAGE(PG8_SA(1, 0), a3, voffA);
            PG8_BAR; PG8_WAIT_L(0); PG8_MMA(1, 0, At, B0); PG8_BAR; PG8_SCHED;
            PG8_STAGE(PG8_SB(1, 1), b3 + hstep, voffB);
            PG8_WAIT_V(6); PG8_BAR; PG8_MMA(1, 1, At, B1); PG8_BAR;
            }
        }
        if constexpr (ALIGN_EPI) { if (wr == 0) PG8_BAR; }
        if constexpr (!Epi::AFTER_DRAIN) { E(acc, cur, wr, wc, fr, fq); S.done(cur); }
        if (!has_next) break;
#pragma unroll
        for (int a = 0; a < 2; ++a)
#pragma unroll
            for (int b = 0; b < 2; ++b)
#pragma unroll
                for (int m = 0; m < 4; ++m)
#pragma unroll
                    for (int n = 0; n < 2; ++n) acc[a][b][m][n] = (f32x4){0.f, 0.f, 0.f, 0.f};
        cur = nxt; cA = nA; cB = nB; ++ui;
        if constexpr (ALIGN_EPI) { if (wr == 1) PG8_BAR; }
    }
    PG8_WAIT_V(0);
    if constexpr (!ALIGN_EPI) { if (wr == 0) PG8_BAR; }
    PG8_BAR;
    if constexpr (Epi::AFTER_DRAIN) { E.fused(acc, cur, wr, wc, fr, fq, lds, wid, lane); S.done(cur); }
#undef PG8_SA
#undef PG8_SB
#undef PG8_STAGE
#undef PG8_LDA
#undef PG8_LDB
#undef PG8_MMA
#undef PG8_WAIT_V
#undef PG8_WAIT_L
#undef PG8_BAR
#undef PG8_SCHED
}
}

#define GAS __attribute__((address_space(1)))
#define LAS __attribute__((address_space(3)))
#define XB_TMO      128
#define XB_XCNT(j)  (256  + 64 * (j))
#define XB_XSUB(j)  (1280 + 64 * (j))
#define XB_XGEN(j)  (2304 + 64 * (j))
#define XB_TOP      3328
#define XB_TOPGEN   3392
#define XCD_BAR_WORDS 3456
#define XB_SPIN_CAP (1u << 18)
__device__ __forceinline__ unsigned xb_ld(unsigned* p)              { return __hip_atomic_load(p, __ATOMIC_RELAXED, __HIP_MEMORY_SCOPE_AGENT); }
__device__ __forceinline__ unsigned xb_add(unsigned* p, unsigned v) { return __hip_atomic_fetch_add(p, v, __ATOMIC_RELAXED, __HIP_MEMORY_SCOPE_AGENT); }
__device__ __forceinline__ unsigned xb_xcc_id() { return (unsigned)__builtin_amdgcn_s_getreg((3 << 11) | 20) & 0xFu; }
#define XB_SPIN(cond, bar) do { unsigned _sp = 0; while (cond) { __builtin_amdgcn_s_sleep(1); \
    if ((++_sp & 255u) == 0u) { if (xb_ld(&(bar)[XB_TMO])) break; if (_sp > XB_SPIN_CAP) { atomicAdd(&(bar)[XB_TMO], 1u); break; } } } } while (0)
struct XcdBarrier { unsigned* bar; unsigned x; volatile LAS unsigned* st; };
__device__ __forceinline__ XcdBarrier xcd_barrier_post(unsigned* bar, volatile LAS unsigned* st) {
    XcdBarrier b; b.bar = bar; b.x = xb_xcc_id(); b.st = st;
    if (threadIdx.x == 0) (void)xb_add(&bar[XB_XCNT(b.x)], 1u);
    return b;
}
__device__ __forceinline__ void xcd_barrier_complete(unsigned* bar, unsigned x, unsigned& nloc, unsigned& nx) {
    const unsigned G = gridDim.x * gridDim.y * gridDim.z;
    unsigned sum, cnt, mine, sp = 0u;
    for (;;) {
        sum = 0u; cnt = 0u; mine = 0u;
#pragma unroll
        for (unsigned j = 0; j < 16; ++j) { const unsigned c = xb_ld(&bar[XB_XCNT(j)]); sum += c; cnt += (c > 0u) ? 1u : 0u; mine = (j == x) ? c : mine; }
        if (sum == G) break;
        __builtin_amdgcn_s_sleep(1);
        if ((++sp & 255u) == 0u) { if (xb_ld(&bar[XB_TMO])) break; if (sp > XB_SPIN_CAP) { atomicAdd(&bar[XB_TMO], 1u); break; } }
    }
    nloc = mine > 0u ? mine : 1u; nx = cnt > 0u ? cnt : 1u;
}
__device__ __forceinline__ void xcd_barrier(const XcdBarrier& b) {
    asm volatile("s_waitcnt vmcnt(0)" ::: "memory");
    __syncthreads();
    if (threadIdx.x == 0) {
        unsigned* bar = b.bar;
        __builtin_amdgcn_s_waitcnt(0);
        unsigned nloc = b.st[0], nx = b.st[1];
        if (nloc == 0u) { xcd_barrier_complete(bar, b.x, nloc, nx); b.st[0] = nloc; b.st[1] = nx; }
        const unsigned old = xb_add(&bar[XB_XSUB(b.x)], 1u);
        const unsigned gen = old / nloc;
        if (old + 1u == (gen + 1u) * nloc) {
            __builtin_amdgcn_fence(__ATOMIC_RELEASE, "agent");
            asm volatile("s_waitcnt vmcnt(0)" ::: "memory");
            const unsigned og = xb_add(&bar[XB_TOP], 1u);
            const unsigned tg = og / nx;
            if (og + 1u == (tg + 1u) * nx) xb_add(&bar[XB_TOPGEN], 1u);
            else XB_SPIN(xb_ld(&bar[XB_TOPGEN]) == tg, bar);
            __builtin_amdgcn_fence(__ATOMIC_ACQUIRE, "agent");
            xb_add(&bar[XB_XGEN(b.x)], 1u);
            asm volatile("s_waitcnt vmcnt(0)" ::: "memory");
        } else {
            XB_SPIN(xb_ld(&bar[XB_XGEN(b.x)]) == gen, bar);
            __builtin_amdgcn_fence(__ATOMIC_ACQUIRE, "agent");
            asm volatile("s_waitcnt vmcnt(0)" ::: "memory");
        }
    }
    __syncthreads();
}

#ifndef PHASE_MASK
#define PHASE_MASK 0xFFF
#endif
constexpr int NWAVES = 8;
constexpr int RING_OFF = 0, RING_BYTES = 131072, LDSCTL_OFF = RING_BYTES, MISC_OFF = LDSCTL_OFF + 320, LDS_BYTES = 147456;
constexpr int CW_BAR = 4096;
constexpr size_t CTL_ZERO_BYTES = 64 * 1024;

__global__ void __launch_bounds__(NWAVES * 64, 2) mega_fwd(Ptrs P) {
    extern __shared__ __attribute__((aligned(16))) unsigned char lds[];
    const int tid = threadIdx.x, lane = tid & 63, wave = __builtin_amdgcn_readfirstlane(tid >> 6);
    const int G = gridDim.x, bx = blockIdx.x, vcu = (G % 8 == 0) ? (bx % 8) * (G / 8) + bx / 8 : bx;
    const int gw = vcu * NWAVES + wave, ngw = G * NWAVES;
    for (int u = tid; u < (LDS_BYTES - LDSCTL_OFF) / 4; u += NWAVES * 64) ((LAS unsigned*)((LAS unsigned char*)lds + LDSCTL_OFF))[u] = 0u;
    __syncthreads();
    unsigned char* ws = P.ws;
    XcdBarrier bar = xcd_barrier_post((unsigned*)(ws + WS_CTL) + CW_BAR, (volatile LAS unsigned*)((LAS unsigned char*)lds + MISC_OFF) + 8);
    bf16 *XN = (bf16*)(ws + WS_XN), *WIN = (bf16*)(ws + WS_WIN), *ACAT = (bf16*)(ws + WS_ACAT), *Kb = (bf16*)(ws + WS_K), *VT = (bf16*)(ws + WS_VT), *U = (bf16*)(ws + WS_U);
    bf16 *RATIO = (bf16*)(ws + WS_RATIO), *SR = (bf16*)(ws + WS_SR), *WCAT = (bf16*)(ws + WS_WCAT), *MIXED = (bf16*)(ws + WS_MIXED), *WOUT = (bf16*)(ws + WS_WOUT);
    bf16 *X1B = (bf16*)(ws + WS_X1B), *WFF1 = (bf16*)(ws + WS_WFF1), *WFF2 = (bf16*)(ws + WS_WFF2), *HFF = (bf16*)(ws + WS_HFF);
    float* SS1 = (float*)(ws + WS_SS1);

    if (PHASE_MASK & 1) p0_prologue(P, (float*)(lds + RING_OFF + wave * 16384), gw, ngw, lane);
    xcd_barrier(bar);
    PG8_LAS unsigned char* ring = (PG8_LAS unsigned char*)lds + RING_OFF;
    float* SS2 = (float*)(ws + WS_SS2);
    if (PHASE_MASK & 2) { pg8::Gemm g{XN, WIN, M, DIN, D}; pg8::StaticOrder S; S.init(M, DIN, G, bx);
      pg8::EpiP1 E{(const float*)(ws + WS_PAR) + PB_BIN, ACAT, Kb, VT, U, RATIO, SR};
      pg8::gemm_phase<pg8::EpiP1, pg8::StaticOrder, true, true>(ring, g, S, E); }
    xcd_barrier(bar);
    if (PHASE_MASK & 4) for (int u = gw; u < NB * NH * ROWS * 4; u += ngw) attn_unit(u >> 10, (u >> 7) & 7, (u >> 2) & 31, u & 3, ACAT, Kb, VT, (const float*)(ws + WS_PAR) + PB_RPB, lane);
    if (PHASE_MASK & 8) for (int u = gw; u < NB * NCHUNK * 16 * 4; u += ngw) rec_unit<false>(u >> 11, (u >> 6) & 31, (u >> 2) & 15, u & 3, ws, lane);
    xcd_barrier(bar);
    if (PHASE_MASK & 16) for (int u = gw; u < NB * NCHUNK * 16 * 4; u += ngw) rec_unit<true>(u >> 11, (u >> 6) & 31, (u >> 2) & 15, u & 3, ws, lane);
    xcd_barrier(bar);
    if (PHASE_MASK & 32) { pg8::Gemm g{ACAT, WCAT, M, D, KCAT}; pg8::StaticOrder S; S.init(M, D, G, bx);
      pg8::EpiP3 E{RATIO, SR, MIXED};
      pg8::gemm_phase<pg8::EpiP3, pg8::StaticOrder, true, true>(ring, g, S, E); }
    xcd_barrier(bar);
    if (PHASE_MASK & 64) { pg8::Gemm g{MIXED, WOUT, M, D, D}; pg8::StaticOrder S; S.init(M, D, G, bx);
      pg8::EpiP4 E{P.x, P.out, X1B, SS1};
      pg8::gemm_phase<pg8::EpiP4, pg8::StaticOrder, true, true>(ring, g, S, E); }
    xcd_barrier(bar);
    if (PHASE_MASK & 128) { pg8::Gemm g{X1B, WFF1, M, DFF, D}; pg8::StaticOrder S; S.init(M, DFF, G, bx);
      pg8::EpiP5 E{SS1, HFF};
      pg8::gemm_phase<pg8::EpiP5, pg8::StaticOrder, true, true>(ring, g, S, E); }
    xcd_barrier(bar);
    if (PHASE_MASK & 256) { pg8::Gemm g{HFF, WFF2, M, D, DFF}; pg8::StaticOrder S; S.init(M, D, G, bx);
      pg8::EpiP6 E{P.out, SS2};
      pg8::gemm_phase<pg8::EpiP6, pg8::StaticOrder, true, true>(ring, g, S, E); }
    xcd_barrier(bar);
    for (int m = gw; m < M; m += ngw) {
        f32x4* xr = (f32x4*)(P.out + (size_t)m * D) + lane; f32x4 v[4];
#pragma unroll
        for (int j = 0; j < 4; ++j) v[j] = xr[64 * j];
        const f32x4* sp = (const f32x4*)(SS2 + (size_t)m * 16); const f32x4 s0 = sp[0], s1 = sp[1], s2 = sp[2], s3 = sp[3];
        const float tot = ((s0[0] + s0[1]) + (s0[2] + s0[3])) + ((s1[0] + s1[1]) + (s1[2] + s1[3])) + ((s2[0] + s2[1]) + (s2[2] + s2[3])) + ((s3[0] + s3[1]) + (s3[2] + s3[3]));
        const float rstd = 1.0f / sqrtf(tot * (1.0f / D) + EPS);
#pragma unroll
        for (int j = 0; j < 4; ++j) { const f32x4 gg = ((const f32x4*)((const float*)(ws + WS_PAR) + PB_GF))[lane + 64 * j]; xr[64 * j] = v[j] * rstd * gg; }
    }
}

extern "C" void kernel_launch(void* const* d_in, const int* in_sizes, int n_in, void* d_out, int out_size, void* d_ws, size_t ws_size, hipStream_t stream) {
    static int grid = 0;
    if (grid == 0) {
        if (n_in != 19 || out_size != M * D || ws_size < WS_END) { fprintf(stderr, "kernel_launch: unexpected shapes (n_in %d out %d ws %zu)\n", n_in, out_size, ws_size); grid = -1; return; }
        int dev = 0, cus = 0, per_cu = 0;
        if (hipGetDevice(&dev) != hipSuccess || hipDeviceGetAttribute(&cus, hipDeviceAttributeMultiprocessorCount, dev) != hipSuccess) { grid = -1; return; }
        if (hipFuncSetAttribute((const void*)mega_fwd, hipFuncAttributeMaxDynamicSharedMemorySize, LDS_BYTES) != hipSuccess) { fprintf(stderr, "kernel_launch: hipFuncSetAttribute failed\n"); grid = -1; return; }
        if (hipOccupancyMaxActiveBlocksPerMultiprocessor(&per_cu, (const void*)mega_fwd, NWAVES * 64, LDS_BYTES) != hipSuccess || per_cu < 1) { fprintf(stderr, "kernel_launch: occupancy query says %d blocks/CU\n", per_cu); per_cu = 1; }
        (void)hipGetLastError();
        grid = cus;
    }
    if (grid < 0) return;
    Ptrs P{};
    const float** pf = (const float**)&P;
    for (int i = 0; i < 19; ++i) pf[i] = (const float*)d_in[i];
    P.out = (float*)d_out; P.ws = (unsigned char*)d_ws;
    (void)hipMemsetAsync((char*)d_ws + WS_CTL, 0, CTL_ZERO_BYTES, stream);
    hipLaunchKernelGGL(mega_fwd, dim3(grid), dim3(NWAVES * 64), LDS_BYTES, stream, P);
}
```
